# Optimizing an MI355X kernel written in HIP

```python
import math
import jax
import jax.numpy as jnp
from jax import lax
import numpy as np

D_MODEL = 1024
BATCH = 2
SEQ = 8192
DEPTH = 1
DEC_BATCH = 128
DEC_SEQ = 8
PAST_LEN = 16384
PAGE_SIZE = 128

HEAD_DIM = 64
ATT_HEADS = (D_MODEL // 2) // HEAD_DIM
ATT_KV_HEADS = ATT_HEADS // 4
ATT_GROUP = ATT_HEADS // ATT_KV_HEADS
WINDOW = 128
ATT_BLOCK = WINDOW
ROPE_THETA = 10000.0
GLA_HEADS = 4
GLA_DK = (D_MODEL // 4) // GLA_HEADS
GLA_DV = (D_MODEL // 2) // GLA_HEADS
GLA_RANK = 16
GLA_GATE_TEMP = 16.0
GLA_CHUNK = 16
D_FF = 4 * D_MODEL
ATT_WIDTH = ATT_HEADS * HEAD_DIM
KV_WIDTH = ATT_KV_HEADS * HEAD_DIM
GLA_KW = GLA_HEADS * GLA_DK
GLA_VW = GLA_HEADS * GLA_DV
MIX_WIDTH = ATT_WIDTH + GLA_VW
IN_WIDTH = ATT_WIDTH + 2 * KV_WIDTH + 2 * GLA_KW + 2 * GLA_VW + GLA_RANK
EPS = 1e-6

kernel_name = "hymba_swa_sink_gla_sandwich_step"


def rms_norm(x, g):
    xf = x.astype(jnp.float32)
    y = xf * lax.rsqrt(jnp.mean(xf * xf, axis=-1, keepdims=True) + EPS)
    return (y * g.astype(jnp.float32)).astype(x.dtype)


def rope(x, pos):
    half = HEAD_DIM // 2
    inv = ROPE_THETA ** (-jnp.arange(half, dtype=jnp.float32) / half)
    ang = pos.astype(jnp.float32)[:, None] * inv[None, :]
    cos = jnp.cos(ang)[:, None, :]
    sin = jnp.sin(ang)[:, None, :]
    xf = x.astype(jnp.float32)
    x1, x2 = xf[..., :half], xf[..., half:]
    return jnp.concatenate([x1 * cos - x2 * sin, x2 * cos + x1 * sin], axis=-1).astype(x.dtype)


def sink_softmax(scores, mask, sink):
    scores = jnp.where(mask, scores, -jnp.inf)
    m = jnp.maximum(jnp.max(scores, axis=-1, keepdims=True), sink)
    p = jnp.exp(scores - m)
    return p / (jnp.sum(p, axis=-1, keepdims=True) + jnp.exp(sink - m))


def swa_banded(q, k, v, sinks):
    B, T = q.shape[:2]
    L = ATT_BLOCK
    nb = T // L
    qb = q.reshape(B, nb, L, ATT_KV_HEADS, ATT_GROUP, HEAD_DIM)
    kb = k.reshape(B, nb, L, ATT_KV_HEADS, HEAD_DIM)
    vb = v.reshape(B, nb, L, ATT_KV_HEADS, HEAD_DIM)
    kk = jnp.concatenate([jnp.concatenate([jnp.zeros_like(kb[:, :1]), kb[:, :-1]], 1), kb], 2)
    vv = jnp.concatenate([jnp.concatenate([jnp.zeros_like(vb[:, :1]), vb[:, :-1]], 1), vb], 2)
    scores = jnp.einsum('bnqhgd,bnkhd->bnhgqk', qb, kk,
                        preferred_element_type=jnp.float32) * (HEAD_DIM ** -0.5)
    qi = jnp.arange(L)[:, None] + L
    ki = jnp.arange(2 * L)[None, :]
    rel = qi - ki
    band = (rel >= 0) & (rel < WINDOW)
    blk_ok = (jnp.arange(nb)[:, None] > 0) | (jnp.arange(2 * L)[None, :] >= L)
    mask = (band[None] & blk_ok[:, None, :])[None, :, None, None]
    sink = sinks.astype(jnp.float32).reshape(ATT_KV_HEADS, ATT_GROUP, 1, 1)
    p = sink_softmax(scores, mask, sink)
    out = jnp.einsum('bnhgqk,bnkhd->bnqhgd', p.astype(v.dtype), vv)
    return out.reshape(B, T, ATT_WIDTH)


def swa_window(q, k_all, v_all, sinks):
    B, T = q.shape[:2]
    qg = q.reshape(B, T, ATT_KV_HEADS, ATT_GROUP, HEAD_DIM)
    scores = jnp.einsum('bqhgd,bkhd->bhgqk', qg, k_all,
                        preferred_element_type=jnp.float32) * (HEAD_DIM ** -0.5)
    rel = (jnp.arange(T)[:, None] + WINDOW) - jnp.arange(WINDOW + T)[None, :]
    mask = (rel >= 0) & (rel < WINDOW)
    sink = sinks.astype(jnp.float32).reshape(ATT_KV_HEADS, ATT_GROUP, 1, 1)
    p = sink_softmax(scores, mask, sink)
    out = jnp.einsum('bhgqk,bkhd->bqhgd', p.astype(v_all.dtype), v_all)
    return out.reshape(B, T, ATT_WIDTH)


def gla_chunked(q, k, v, log_a, s0):
    B, T = q.shape[:2]
    C = math.gcd(T, GLA_CHUNK)
    n = T // C
    f32 = jnp.float32
    qc = q.astype(f32).reshape(B, n, C, GLA_HEADS, GLA_DK) * (GLA_DK ** -0.5)
    kc = k.astype(f32).reshape(B, n, C, GLA_HEADS, GLA_DK)
    vc = v.astype(f32).reshape(B, n, C, GLA_HEADS, GLA_DV)
    b = jnp.cumsum(log_a.reshape(B, n, C, GLA_HEADS, GLA_DK), axis=2)
    causal = jnp.tril(jnp.ones((C, C), dtype=bool))[:, :, None, None]
    diff = b[:, :, :, None] - b[:, :, None, :]
    k_rel = jnp.exp(jnp.where(causal, diff, -jnp.inf)) * kc[:, :, None]
    attn = jnp.einsum('bnthk,bntshk->bnhts', qc, k_rel)
    o_intra = jnp.einsum('bnhts,bnshv->bnthv', attn, vc)
    b_last = b[:, :, -1:]
    q_dec = qc * jnp.exp(b)
    k_dec = kc * jnp.exp(b_last - b)
    a_blk = jnp.exp(b_last[:, :, 0])

    def step(S, xs):
        qd, kd, vv, ab = xs
        o = jnp.einsum('bthk,bhkv->bthv', qd, S)
        S = ab[..., None] * S + jnp.einsum('bthk,bthv->bhkv', kd, vv)
        return S, o

    xs = (jnp.moveaxis(q_dec, 1, 0), jnp.moveaxis(k_dec, 1, 0),
          jnp.moveaxis(vc, 1, 0), jnp.moveaxis(a_blk, 1, 0))
    S, o_inter = lax.scan(step, s0, xs)
    o = o_intra + jnp.moveaxis(o_inter, 0, 1)
    return o.reshape(B, T, GLA_HEADS, GLA_DV), S


def hybrid_layer(x, pos, k_win, v_win, s0, w_in, w_gk2, b_gk, g_gla, sinks, w_out,
                 g_mix_pre, g_mix_post, g_ffn_pre, g_ffn_post, w_up, w_down):
    B, T, _ = x.shape
    h = rms_norm(x, g_mix_pre)
    proj = jnp.einsum('btd,de->bte', h, w_in)
    widths = (ATT_WIDTH, KV_WIDTH, KV_WIDTH, GLA_KW, GLA_KW, GLA_VW, GLA_VW, GLA_RANK)
    points, acc = [], 0
    for wdt in widths[:-1]:
        acc += wdt
        points.append(acc)
    q, k, v, gq, gk, gv, gr, glr = jnp.split(proj, points, axis=-1)

    q = rope(q.reshape(B, T, ATT_HEADS, HEAD_DIM), pos)
    k = rope(k.reshape(B, T, ATT_KV_HEADS, HEAD_DIM), pos)
    v = v.reshape(B, T, ATT_KV_HEADS, HEAD_DIM)
    if k_win is None:
        attn = swa_banded(q, k, v, sinks)
        k_all, v_all = k, v
    else:
        k_all = jnp.concatenate([k_win.astype(k.dtype), k], axis=1)
        v_all = jnp.concatenate([v_win.astype(v.dtype), v], axis=1)
        attn = swa_window(q, k_all, v_all, sinks)
    new_k = k_all[:, -WINDOW:]
    new_v = v_all[:, -WINDOW:]

    log_a = jax.nn.log_sigmoid(
        (jnp.einsum('btr,rk->btk', glr, w_gk2) + b_gk).astype(jnp.float32)) / GLA_GATE_TEMP
    if s0 is None:
        s_init = jnp.zeros((B, GLA_HEADS, GLA_DK, GLA_DV), jnp.float32)
    else:
        s_init = s0.astype(jnp.float32)
    o, s_new = gla_chunked(gq.reshape(B, T, GLA_HEADS, GLA_DK), gk.reshape(B, T, GLA_HEADS, GLA_DK),
                           gv.reshape(B, T, GLA_HEADS, GLA_DV),
                           log_a.reshape(B, T, GLA_HEADS, GLA_DK), s_init)
    o = rms_norm(o, g_gla) * jax.nn.silu(gr.astype(jnp.float32)).reshape(B, T, GLA_HEADS, GLA_DV)
    gla_out = o.reshape(B, T, GLA_VW).astype(x.dtype)

    mix = jnp.einsum('bte,ed->btd', jnp.concatenate([attn.astype(x.dtype), gla_out], axis=-1), w_out)
    x = x + rms_norm(mix, g_mix_post)

    h = rms_norm(x, g_ffn_pre)
    u = jax.nn.relu(jnp.einsum('btd,df->btf', h, w_up))
    f = jnp.einsum('btf,fd->btd', u * u, w_down)
    x = x + rms_norm(f, g_ffn_post)
    return x, new_k, new_v, s_new.astype(x.dtype)


def setup_inputs(seed: int = 0) -> dict:
    key = jax.random.key(seed)
    ks = jax.random.split(key, 20)
    nrm = jax.random.normal
    f32 = jnp.float32
    return {
        "x_prompt": nrm(ks[0], (BATCH, SEQ, D_MODEL), f32),
        "x_sample": nrm(ks[1], (DEC_BATCH, DEC_SEQ, D_MODEL), f32),
        "cache_k": nrm(ks[2], (DEPTH, DEC_BATCH, WINDOW, ATT_KV_HEADS, HEAD_DIM), f32),
        "cache_v": nrm(ks[3], (DEPTH, DEC_BATCH, WINDOW, ATT_KV_HEADS, HEAD_DIM), f32),
        "state_gla": nrm(ks[4], (DEPTH, DEC_BATCH, GLA_HEADS, GLA_DK, GLA_DV), f32),
        "w_in": nrm(ks[5], (DEPTH, D_MODEL, IN_WIDTH), f32) * D_MODEL ** -0.5,
        "w_gk2": nrm(ks[6], (DEPTH, GLA_RANK, GLA_KW), f32) * GLA_RANK ** -0.5,
        "b_gk": 0.02 * nrm(ks[7], (DEPTH, GLA_KW), f32),
        "g_gla": 1.0 + 0.05 * nrm(ks[8], (DEPTH, GLA_DV), f32),
        "sinks": 0.5 * nrm(ks[9], (DEPTH, ATT_HEADS), f32),
        "w_out": nrm(ks[10], (DEPTH, MIX_WIDTH, D_MODEL), f32) * MIX_WIDTH ** -0.5,
        "g_mix_pre": 1.0 + 0.05 * nrm(ks[11], (DEPTH, D_MODEL), f32),
        "g_mix_post": 1.0 + 0.05 * nrm(ks[12], (DEPTH, D_MODEL), f32),
        "g_ffn_pre": 1.0 + 0.05 * nrm(ks[13], (DEPTH, D_MODEL), f32),
        "g_ffn_post": 1.0 + 0.05 * nrm(ks[14], (DEPTH, D_MODEL), f32),
        "w_up": nrm(ks[15], (DEPTH, D_MODEL, D_FF), f32) * D_MODEL ** -0.5,
        "w_down": nrm(ks[16], (DEPTH, D_FF, D_MODEL), f32) * D_FF ** -0.5,
    }


def reference(x_prompt, x_sample, cache_k, cache_v, state_gla, w_in, w_gk2, b_gk, g_gla, sinks,
              w_out, g_mix_pre, g_mix_post, g_ffn_pre, g_ffn_post, w_up, w_down):
    pos_p = jnp.arange(x_prompt.shape[1], dtype=jnp.int32)
    pos_s = PAST_LEN + jnp.arange(x_sample.shape[1], dtype=jnp.int32)
    yp, ys = x_prompt, x_sample
    kp, vp, sp, ksm, vsm, ssm = [], [], [], [], [], []
    for l in range(DEPTH):
        lw = (w_in[l], w_gk2[l], b_gk[l], g_gla[l], sinks[l], w_out[l],
              g_mix_pre[l], g_mix_post[l], g_ffn_pre[l], g_ffn_post[l], w_up[l], w_down[l])
        yp, k1, v1, s1 = hybrid_layer(yp, pos_p, None, None, None, *lw)
        ys, k2, v2, s2 = hybrid_layer(ys, pos_s, cache_k[l], cache_v[l], state_gla[l], *lw)
        kp.append(k1); vp.append(v1); sp.append(s1)
        ksm.append(k2); vsm.append(v2); ssm.append(s2)
    return (yp, ys, jnp.stack(kp), jnp.stack(vp), jnp.stack(sp),
            jnp.stack(ksm), jnp.stack(vsm), jnp.stack(ssm))
```

```cpp
#include <hip/hip_cooperative_groups.h>
#include <cmath>
#include <hip/hip_runtime.h>
#include <cstdio>
#include <cstdint>
namespace pg8 {
#define PG8_LAS __attribute__((address_space(3)))
typedef unsigned short bf16_t;
typedef short bf16x8 __attribute__((ext_vector_type(8)));
typedef float f32x4 __attribute__((ext_vector_type(4)));
typedef unsigned u32x4 __attribute__((ext_vector_type(4)));
constexpr int BM = 256, BK = 64, HALF = 128, HTB = HALF * BK * 2  , STAGE_BYTES = 8 * HTB, NXCD = 8, WGM = 8;

__host__ __device__ __forceinline__ int lds_byte(int r, int c) { const int st = (r >> 4) * 2 + (c >> 5), rr = r & 15, cc = c & 31, ob = rr * 64 + cc * 2; return st * 1024 + (ob ^ (((ob >> 9) & 1) << 5)); }
__host__ __device__ __forceinline__ void stage_rc(int b, int& R, int& C) { const int st = b / 1024, sb = b % 1024, swz = sb ^ (((sb >> 9) & 1) << 5); R = (st >> 1) * 16 + swz / 64; C = (st & 1) * 32 + (swz % 64) / 2; }
__host__ __device__ __forceinline__ int perm32(int rho) { const int n = rho >> 4, i = rho & 15; return 8 * (i >> 2) + 4 * n + (i & 3); }

struct Unit { int pm, pn; };
struct Gemm { const bf16_t* A; const bf16_t* Bt; int M, N, K; };

struct StaticOrder {
    int nM, nN, nwg, G, c;
    __host__ __device__ void init(int M, int N, int G_, int c_) { nM = M / BM; nN = N / BM; nwg = nM * nN; G = G_; c = c_; }
    __host__ __device__ bool next(int i, Unit& u) const {
        const long L = (long)i * G + c; if (L >= nwg) return false;
        int wgid = (int)L; { const int q = nwg / NXCD, r = nwg % NXCD, xcd = wgid % NXCD, off = wgid / NXCD; wgid = (xcd < r ? xcd * (q + 1) : r * (q + 1) + (xcd - r) * q) + off; }
        const int nig = WGM * nN, gid = wgid / nig, fm = gid * WGM, gsz = (nM - fm) < WGM ? (nM - fm) : WGM;
        u.pm = fm + ((wgid % nig) % gsz); u.pn = (wgid % nig) / gsz; return true;
    }
    __device__ __forceinline__ void a_ready(const Unit&) const {}
    __device__ __forceinline__ void done(const Unit&) const {}
};

__device__ __forceinline__ unsigned cvt_pk_bf16(float lo, float hi) { unsigned r; asm volatile("v_cvt_pk_bf16_f32 %0, %1, %2" : "=v"(r) : "v"(lo), "v"(hi)); return r; }
typedef float f32x2 __attribute__((ext_vector_type(2)));
template <int ACT, bool STATS> struct EpiMk {
    static constexpr bool PERM = true, AFTER_DRAIN = false;
    bf16_t* O; int ldc; float* ss;
    __device__ __forceinline__ void operator()(const f32x4 (&acc)[2][2][4][2], const Unit& u, int wr, int wc, int fr, int fq) const {
        const int row0 = u.pm * BM + wr * 64 + fr; const int col0 = u.pn * BM + wc * 32 + 8 * fq;
#pragma unroll
        for (int ai = 0; ai < 2; ++ai)
#pragma unroll
            for (int m = 0; m < 4; ++m) { const int row = row0 + ai * HALF + m * 16; bf16_t* rowp = O + (size_t)row * ldc + col0; float s = 0.f;
#pragma unroll
                for (int bj = 0; bj < 2; ++bj) { f32x4 v0 = acc[ai][bj][m][0], v1 = acc[ai][bj][m][1];
                    if (ACT == 1) {
#pragma unroll
                        for (int e = 0; e < 4; ++e) { const float a = fmaxf(v0[e], 0.f), b = fmaxf(v1[e], 0.f); v0[e] = a * a; v1[e] = b * b; } }
                    if (STATS) s += (v0[0] * v0[0] + v0[1] * v0[1]) + (v0[2] * v0[2] + v0[3] * v0[3]) + (v1[0] * v1[0] + v1[1] * v1[1]) + (v1[2] * v1[2] + v1[3] * v1[3]);
                    u32x4 w; w.x = cvt_pk_bf16(v0[0], v0[1]); w.y = cvt_pk_bf16(v0[2], v0[3]); w.z = cvt_pk_bf16(v1[0], v1[1]); w.w = cvt_pk_bf16(v1[2], v1[3]);
                    *(u32x4*)(rowp + bj * HALF) = w; }
                if (STATS) { s += __shfl_xor(s, 16); s += __shfl_xor(s, 32); if (fq == 0) ss[(size_t)row * 16 + u.pn * 4 + wc] = s; } }
    }
};

template <class Epi, class Sched, bool ALIGN_EPI = false, bool SP2 = false>
__device__ __forceinline__ void gemm_phase(PG8_LAS unsigned char* lds, const Gemm g, const Sched& S, const Epi& E) {
    const int tid = threadIdx.x, wid = __builtin_amdgcn_readfirstlane(tid >> 6), lane = tid & 63, wr = wid >> 2, wc = wid & 3, fr = lane & 15, fq = lane >> 4;
    const int K = g.K, nt = K / BK;
    unsigned voffA[2], voffB[2];
#pragma unroll
    for (int i = 0; i < 2; ++i) { int R, C; stage_rc(tid * 16 + i * 8192, R, C); const int Rb = Epi::PERM ? ((R & ~31) + perm32(R & 31)) : R;
        voffA[i] = (unsigned)(R * K + C) * 2u; voffB[i] = (unsigned)(Rb * K + C) * 2u; }
    const size_t kstep = (size_t)(BK * 2);
    const size_t hstep = (size_t)HALF * K * 2;
    const size_t tstep = 2 * hstep;
    const unsigned ldsw = (unsigned)wid * 1024u;
    const int aoff = lds_byte(wr * 64 + fr, fq * 8), boff = lds_byte(wc * 32 + fr, fq * 8);
#define PG8_SA(b, h) (((b) * 2 + (h)) * HTB)
#define PG8_SB(b, h) ((4 + (b) * 2 + (h)) * HTB)
#define PG8_STAGE(bufoff, gbase, voff) do { _Pragma("unroll") for (int _i = 0; _i < 2; ++_i) \
        __builtin_amdgcn_global_load_lds((const unsigned*)((const char*)(gbase) + (voff)[_i]), (PG8_LAS unsigned*)(lds + (bufoff) + ldsw + _i * 8192), 16, 0, 0); } while (0)
#define PG8_LDA(dst, b, h) do { _Pragma("unroll") for (int m = 0; m < 4; ++m) _Pragma("unroll") for (int k = 0; k < 2; ++k) dst[m][k] = *(const PG8_LAS bf16x8*)(lds + PG8_SA(b, h) + aoff + m * 2048 + k * 1024); } while (0)
#define PG8_LDB(dst, b, h) do { _Pragma("unroll") for (int n = 0; n < 2; ++n) _Pragma("unroll") for (int k = 0; k < 2; ++k) dst[n][k] = *(const PG8_LAS bf16x8*)(lds + PG8_SB(b, h) + boff + n * 2048 + k * 1024); } while (0)
#define PG8_MMA(ai, bj, At, Bt) do { __builtin_amdgcn_s_setprio(1); _Pragma("unroll") for (int m = 0; m < 4; ++m) _Pragma("unroll") for (int n = 0; n < 2; ++n) _Pragma("unroll") for (int k = 0; k < 2; ++k) \
        acc[ai][bj][m][n] = __builtin_amdgcn_mfma_f32_16x16x32_bf16(Bt[n][k], At[m][k], acc[ai][bj][m][n], 0, 0, 0); __builtin_amdgcn_s_setprio(0); } while (0)
#define PG8_WAIT_V(n) asm volatile("s_waitcnt vmcnt(" #n ")" ::: "memory")
#define PG8_WAIT_L(n) asm volatile("s_waitcnt lgkmcnt(" #n ")" ::: "memory")
#define PG8_BAR __builtin_amdgcn_s_barrier()
#define PG8_SCHED __builtin_amdgcn_sched_barrier(0)
    Unit cur, nxt; int ui = 0;
    if (!S.next(0, cur)) return;
    f32x4 acc[2][2][4][2];
#pragma unroll
    for (int a = 0; a < 2; ++a)
#pragma unroll
        for (int b = 0; b < 2; ++b)
#pragma unroll
            for (int m = 0; m < 4; ++m)
#pragma unroll
                for (int n = 0; n < 2; ++n) acc[a][b][m][n] = (f32x4){0.f, 0.f, 0.f, 0.f};
    bf16x8 At[4][2], B0[2][2], B1[2][2];
    const char* cA = (const char*)g.A + (size_t)cur.pm * tstep; const char* cB = (const char*)g.Bt + (size_t)cur.pn * tstep;
    S.a_ready(cur);
    if constexpr (SP2) {
        PG8_STAGE(PG8_SB(0, 0), cB, voffB); PG8_STAGE(PG8_SB(0, 1), cB + hstep, voffB); PG8_STAGE(PG8_SA(0, 0), cA, voffA); PG8_STAGE(PG8_SA(0, 1), cA + hstep, voffA);
        if (wr == 1) PG8_BAR;
        PG8_WAIT_V(2); PG8_BAR;
        PG8_STAGE(PG8_SB(1, 0), cB + kstep, voffB); PG8_STAGE(PG8_SA(1, 0), cA + kstep, voffA); PG8_STAGE(PG8_SB(1, 1), cB + hstep + kstep, voffB);
        PG8_WAIT_V(6); PG8_BAR;
    } else {
        PG8_STAGE(PG8_SB(0, 0), cB, voffB); PG8_STAGE(PG8_SA(0, 0), cA, voffA); PG8_STAGE(PG8_SB(0, 1), cB + hstep, voffB); PG8_STAGE(PG8_SA(0, 1), cA + hstep, voffA);
        if (wr == 1) PG8_BAR;
        PG8_WAIT_V(4); PG8_BAR;
        PG8_STAGE(PG8_SB(1, 0), cB + kstep, voffB); PG8_STAGE(PG8_SA(1, 0), cA + kstep, voffA); PG8_STAGE(PG8_SB(1, 1), cB + hstep + kstep, voffB);
        PG8_WAIT_V(6); PG8_BAR;
    }
    for (;;) {
        const bool has_next = S.next(ui + 1, nxt);
        const char* nA = has_next ? (const char*)g.A + (size_t)nxt.pm * tstep : cA; const char* nB = has_next ? (const char*)g.Bt + (size_t)nxt.pn * tstep : cB;
        for (int t = 0; t < nt; t += 2) {
            const bool last = (t == nt - 2);
            const char* a1 = cA + (size_t)(t + 1) * kstep;
            const char* a2 = last ? nA : cA + (size_t)(t + 2) * kstep; const char* b2 = last ? nB : cB + (size_t)(t + 2) * kstep;
            const char* a3 = a2 + kstep; const char* b3 = b2 + kstep;
            if (last && has_next) S.a_ready(nxt);
            if constexpr (SP2) {
            PG8_LDB(B0, 0, 0); PG8_LDB(B1, 0, 1); PG8_SCHED; PG8_LDA(At, 0, 0); PG8_STAGE(PG8_SA(1, 1), a1 + hstep, voffA);
            PG8_WAIT_V(8); PG8_WAIT_L(0); PG8_BAR; PG8_MMA(0, 0, At, B0); PG8_MMA(0, 1, At, B1); PG8_BAR; PG8_SCHED;
            PG8_LDA(At, 0, 1); PG8_STAGE(PG8_SB(0, 0), b2, voffB); PG8_STAGE(PG8_SB(0, 1), b2 + hstep, voffB); PG8_STAGE(PG8_SA(0, 0), a2, voffA);
            PG8_WAIT_V(8); PG8_WAIT_L(0); PG8_BAR; PG8_MMA(1, 0, At, B0); PG8_MMA(1, 1, At, B1); PG8_BAR; PG8_SCHED;
            PG8_LDB(B0, 1, 0); PG8_LDB(B1, 1, 1); PG8_SCHED; PG8_LDA(At, 1, 0); PG8_STAGE(PG8_SA(0, 1), a2 + hstep, voffA);
            PG8_WAIT_V(8); PG8_WAIT_L(0); PG8_BAR; PG8_MMA(0, 0, At, B0); PG8_MMA(0, 1, At, B1); PG8_BAR; PG8_SCHED;
            PG8_LDA(At, 1, 1); PG8_STAGE(PG8_SB(1, 0), b3, voffB); PG8_STAGE(PG8_SB(1, 1), b3 + hstep, voffB); PG8_STAGE(PG8_SA(1, 0), a3, voffA);
            PG8_WAIT_V(8); PG8_WAIT_L(0); PG8_BAR; PG8_MMA(1, 0, At, B0); PG8_MMA(1, 1, At, B1); PG8_BAR; PG8_SCHED;
            } else {
            PG8_LDB(B0, 0, 0); PG8_SCHED; PG8_LDA(At, 0, 0); PG8_STAGE(PG8_SA(1, 1), a1 + hstep, voffA);
            PG8_WAIT_L(8); PG8_BAR; PG8_WAIT_L(0); PG8_MMA(0, 0, At, B0); PG8_BAR; PG8_SCHED;
            PG8_LDB(B1, 0, 1); PG8_STAGE(PG8_SB(0, 0), b2, voffB);
            PG8_BAR; PG8_WAIT_L(0); PG8_MMA(0, 1, At, B1); PG8_BAR;
            PG8_LDA(At, 0, 1); PG8_STAGE(PG8_SA(0, 0), a2, voffA);
            PG8_BAR; PG8_WAIT_L(0); PG8_MMA(1, 0, At, B0); PG8_BAR; PG8_SCHED;
            PG8_STAGE(PG8_SB(0, 1), b2 + hstep, voffB);
            PG8_WAIT_V(6); PG8_BAR; PG8_MMA(1, 1, At, B1); PG8_BAR;
            PG8_LDB(B0, 1, 0); PG8_SCHED; PG8_LDA(At, 1, 0); PG8_STAGE(PG8_SA(0, 1), a2 + hstep, voffA);
            PG8_WAIT_L(8); PG8_BAR; PG8_WAIT_L(0); PG8_MMA(0, 0, At, B0); PG8_BAR; PG8_SCHED;
            PG8_LDB(B1, 1, 1); PG8_STAGE(PG8_SB(1, 0), b3, voffB);
            PG8_BAR; PG8_WAIT_L(0); PG8_MMA(0, 1, At, B1); PG8_BAR;
            PG8_LDA(At, 1, 1); PG8_STAGE(PG8_SA(1, 0), a3, voffA);
            PG8_BAR; PG8_WAIT_L(0); PG8_MMA(1, 0, At, B0); PG8_BAR; PG8_SCHED;
            PG8_STAGE(PG8_SB(1, 1), b3 + hstep, voffB);
            PG8_WAIT_V(6); PG8_BAR; PG8_MMA(1, 1, At, B1); PG8_BAR;
            }
        }
        if constexpr (ALIGN_EPI) { if (wr == 0) PG8_BAR; }
        if constexpr (!Epi::AFTER_DRAIN) { E(acc, cur, wr, wc, fr, fq); S.done(cur); }
        if (!has_next) break;
#pragma unroll
        for (int a = 0; a < 2; ++a)
#pragma unroll
            for (int b = 0; b < 2; ++b)
#pragma unroll
                for (int m = 0; m < 4; ++m)
#pragma unroll
                    for (int n = 0; n < 2; ++n) acc[a][b][m][n] = (f32x4){0.f, 0.f, 0.f, 0.f};
        cur = nxt; cA = nA; cB = nB; ++ui;
        if constexpr (ALIGN_EPI) { if (wr == 1) PG8_BAR; }
    }
    PG8_WAIT_V(0);
    if constexpr (!ALIGN_EPI) { if (wr == 0) PG8_BAR; }
    PG8_BAR;
    if constexpr (Epi::AFTER_DRAIN) { E.fused(acc, cur, wr, wc, fr, fq, lds, wid, lane); S.done(cur); }
#undef PG8_SA
#undef PG8_SB
#undef PG8_STAGE
#undef PG8_LDA
#undef PG8_LDB
#undef PG8_MMA
#undef PG8_WAIT_V
#undef PG8_WAIT_L
#undef PG8_BAR
#undef PG8_SCHED
}
}
#define GAS __attribute__((address_space(1)))
#define LAS __attribute__((address_space(3)))
typedef unsigned short bf16;
typedef unsigned v4u __attribute__((ext_vector_type(4)));
typedef float f32x4 __attribute__((ext_vector_type(4)));
typedef short bf16x8 __attribute__((ext_vector_type(8)));
typedef GAS unsigned gu32;
typedef GAS unsigned long long gu64;
#define RLX_AGENT __ATOMIC_RELAXED, __HIP_MEMORY_SCOPE_AGENT
#define LDS_WAIT() asm volatile("s_waitcnt lgkmcnt(0)" ::: "memory")
#define VM_WAIT() asm volatile("s_waitcnt vmcnt(0)" ::: "memory")
__device__ __forceinline__ unsigned long long rt() { return __builtin_amdgcn_s_memrealtime(); }
__device__ __forceinline__ unsigned f2bf(float f) { unsigned u = __builtin_bit_cast(unsigned, f); return (u + 0x7fffu + ((u >> 16) & 1u)) >> 16; }
__device__ __forceinline__ unsigned pk2(float lo, float hi) { return f2bf(lo) | (f2bf(hi) << 16); }

#define XB_TMO      128
#define XB_XCNT(j)  (256  + 64 * (j))
#define XB_XSUB(j)  (1280 + 64 * (j))
#define XB_XGEN(j)  (2304 + 64 * (j))
#define XB_TOP      3328
#define XB_TOPGEN   3392
#define XCD_BAR_WORDS 3456
#define XB_SPIN_CAP (1u << 18)

__device__ __forceinline__ unsigned xb_ld(unsigned* p)              { return __hip_atomic_load(p, __ATOMIC_RELAXED, __HIP_MEMORY_SCOPE_AGENT); }
__device__ __forceinline__ unsigned xb_add(unsigned* p, unsigned v) { return __hip_atomic_fetch_add(p, v, __ATOMIC_RELAXED, __HIP_MEMORY_SCOPE_AGENT); }
__device__ __forceinline__ unsigned xb_xcc_id() { return (unsigned)__builtin_amdgcn_s_getreg((3 << 11) | 20) & 0xFu; }
#define XB_SPIN(cond, bar) do { unsigned _sp = 0; while (cond) { __builtin_amdgcn_s_sleep(1); \
    if ((++_sp & 255u) == 0u) { if (xb_ld(&(bar)[XB_TMO])) break; if (_sp > XB_SPIN_CAP) { atomicAdd(&(bar)[XB_TMO], 1u); break; } } } } while (0)

struct XcdBarrier {
    unsigned* bar; unsigned x;
    volatile LAS unsigned* st;
};

__device__ __forceinline__ XcdBarrier xcd_barrier_post(unsigned* bar, volatile LAS unsigned* st) {
    XcdBarrier b; b.bar = bar; b.x = xb_xcc_id(); b.st = st;
    if (threadIdx.x == 0) (void)xb_add(&bar[XB_XCNT(b.x)], 1u);
    return b;
}
__device__ __forceinline__ void xcd_barrier_complete(unsigned* bar, unsigned x, unsigned& nloc, unsigned& nx) {
    const unsigned G = gridDim.x * gridDim.y * gridDim.z;
    unsigned sum, cnt, mine, sp = 0u;
    for (;;) {
        sum = 0u; cnt = 0u; mine = 0u;
#pragma unroll
        for (unsigned j = 0; j < 16; ++j) { const unsigned c = xb_ld(&bar[XB_XCNT(j)]); sum += c; cnt += (c > 0u) ? 1u : 0u; mine = (j == x) ? c : mine; }
        if (sum == G) break;
        __builtin_amdgcn_s_sleep(1);
        if ((++sp & 255u) == 0u) { if (xb_ld(&bar[XB_TMO])) break; if (sp > XB_SPIN_CAP) { atomicAdd(&bar[XB_TMO], 1u); break; } }
    }
    nloc = mine > 0u ? mine : 1u; nx = cnt > 0u ? cnt : 1u;
}

__device__ __forceinline__ void xcd_barrier(const XcdBarrier& b) {
    asm volatile("s_waitcnt vmcnt(0)" ::: "memory");
    __syncthreads();
    if (threadIdx.x == 0) {
        unsigned* bar = b.bar;
        __builtin_amdgcn_s_waitcnt(0);
        unsigned nloc = b.st[0], nx = b.st[1];
        if (nloc == 0u) { xcd_barrier_complete(bar, b.x, nloc, nx); b.st[0] = nloc; b.st[1] = nx; }
        const unsigned old = xb_add(&bar[XB_XSUB(b.x)], 1u);
        const unsigned gen = old / nloc;
        if (old + 1u == (gen + 1u) * nloc) {
            __builtin_amdgcn_fence(__ATOMIC_RELEASE, "agent");
            asm volatile("s_waitcnt vmcnt(0)" ::: "memory");
            const unsigned og = xb_add(&bar[XB_TOP], 1u);
            const unsigned tg = og / nx;
            if (og + 1u == (tg + 1u) * nx) xb_add(&bar[XB_TOPGEN], 1u);
            else XB_SPIN(xb_ld(&bar[XB_TOPGEN]) == tg, bar);
            __builtin_amdgcn_fence(__ATOMIC_ACQUIRE, "agent");
            xb_add(&bar[XB_XGEN(b.x)], 1u);
            asm volatile("s_waitcnt vmcnt(0)" ::: "memory");
        } else {
            XB_SPIN(xb_ld(&bar[XB_XGEN(b.x)]) == gen, bar);
            __builtin_amdgcn_fence(__ATOMIC_ACQUIRE, "agent");
            asm volatile("s_waitcnt vmcnt(0)" ::: "memory");
        }
    }
    __syncthreads();
}
#ifndef MK_N_LAUNCHES
#define MK_N_LAUNCHES 10
#endif
constexpr int DM = 1024, NPR = 16384, NSR = 1024, MR = NPR + NSR, SEQ = 8192, NPJ = 2560, FF = 4096, WIN_LD = 2320;
constexpr int C_Q = 0, C_K = 512, C_V = 640, C_GQ = 768, C_GK = 1024, C_GV = 1280, C_GR = 1792, C_Z = 2304;
constexpr float EPSN = 1e-6f, LOG2E = 1.4426950408889634f;
constexpr size_t O_YP = 0, O_YS = 16777216, O_KWP = 17825792, O_VWP = O_KWP + 32768, O_GLP = O_VWP + 32768, O_KWS = O_GLP + 65536, O_VWS = O_KWS + 2097152, O_GLS = O_VWS + 2097152;
constexpr size_t MiB = 1u << 20;
constexpr size_t WS_CTL = 0, CTL_ZERO_BYTES = 64 * 1024;
constexpr size_t WS_WDN = 1 * MiB, WS_WIN = 9 * MiB, WS_WOUT = 14 * MiB, WS_WUP = 16 * MiB;
constexpr size_t WS_XN = 24 * MiB, WS_PROJ = 58 * MiB, WS_MIX = 143 * MiB, WS_ST = 177 * MiB, WS_ABLK = 209 * MiB, WS_ROPE = 210 * MiB, WS_SS = 213 * MiB;
constexpr size_t WS_MIXOUT = 58 * MiB, WS_U = 58 * MiB, WS_F = 24 * MiB, WS_END = 216 * MiB;
constexpr int CW_BAR = 1024;
constexpr int RING_BYTES = 131072, MISC_OFF = RING_BYTES, LDS_BYTES = RING_BYTES + 1024;
constexpr int NPH = 10;

typedef short s16x4 __attribute__((ext_vector_type(4)));
typedef unsigned u32x2 __attribute__((ext_vector_type(2)));
typedef float f32x2v __attribute__((ext_vector_type(2)));
typedef __bf16 bf16x2_t __attribute__((ext_vector_type(2)));
__device__ __forceinline__ unsigned pkbf(float lo, float hi) { f32x2v v = {lo, hi}; bf16x2_t b = __builtin_convertvector(v, bf16x2_t); return __builtin_bit_cast(unsigned, b); }
__device__ __forceinline__ float bflo(unsigned w) { return __uint_as_float(w << 16); }
__device__ __forceinline__ float bfhi(unsigned w) { return __uint_as_float(w & 0xffff0000u); }
__device__ __forceinline__ float bf2f(bf16 b) { return __uint_as_float((unsigned)b << 16); }
__device__ __forceinline__ float wave_sum(float v) {
#pragma unroll
    for (int o = 1; o < 64; o <<= 1) v += __shfl_xor(v, o);
    return v;
}
__device__ __forceinline__ f32x4 mfma16(bf16x8 a, bf16x8 b, f32x4 c) { return __builtin_amdgcn_mfma_f32_16x16x32_bf16(a, b, c, 0, 0, 0); }
__device__ __forceinline__ float logsig16(float z) { return (fminf(z, 0.f) - __logf(1.f + __expf(-fabsf(z)))) * 0.0625f; }

struct Args { const float* in[17]; float* out; unsigned char* ws; double inv_freq[32]; int ph_lo, ph_hi, never, use_bar; };
enum { I_XP = 0, I_XS, I_CK, I_CV, I_SG, I_WIN, I_WGK2, I_BGK, I_GGLA, I_SINK, I_WOUT, I_GMPRE, I_GMPOST, I_GFPRE, I_GFPOST, I_WUP, I_WDN };

__device__ __forceinline__ void p0_transpose_item(const float* W, int ldw, int nblk, int K, bf16* WT, LAS float* scr, int item, int lane) {
    const int kb = item / nblk, nb = item % nblk, k0 = 64 * kb, n0 = 32 * nb;
#pragma unroll 8
    for (int i = 0; i < 32; ++i) { const int kk = 2 * i + (lane >> 5); scr[kk * 33 + (lane & 31)] = W[(size_t)(k0 + kk) * ldw + n0 + (lane & 31)]; }
    LDS_WAIT(); asm volatile("" ::: "memory");
    const int c = lane & 7;
#pragma unroll
    for (int j = 0; j < 4; ++j) { const int n = (lane >> 3) + 8 * j; const LAS float* s = scr + (8 * c) * 33 + n;
        v4u o; o.x = pkbf(s[0 * 33], s[1 * 33]); o.y = pkbf(s[2 * 33], s[3 * 33]); o.z = pkbf(s[4 * 33], s[5 * 33]); o.w = pkbf(s[6 * 33], s[7 * 33]);
        *(v4u*)(WT + (size_t)(n0 + n) * K + k0 + 8 * c) = o; }
    LDS_WAIT(); asm volatile("" ::: "memory");
}
__device__ __forceinline__ const float* xrow_ptr(const Args& a, int m) { return m < NPR ? a.in[I_XP] + (size_t)m * DM : a.in[I_XS] + (size_t)(m - NPR) * DM; }

__device__ __forceinline__ void phase0(const Args& a, LAS unsigned char* L, int G, int bid, int tid, int lane, int wave) {
    unsigned char* ws = a.ws;
    bf16* Win_t = (bf16*)(ws + WS_WIN); bf16* Wout_t = (bf16*)(ws + WS_WOUT); bf16* Wup_t = (bf16*)(ws + WS_WUP); bf16* Wdn_t = (bf16*)(ws + WS_WDN);
    const int gw = bid * 8 + wave, NGW = G * 8;
    LAS float* scr = (LAS float*)(L + wave * 16384);
    constexpr int I_IN = 16 * 72, I_OUT = 16 * 32, I_UP = 16 * 128, I_DN = 64 * 32, NITEMS = I_IN + I_OUT + I_UP + I_DN;
    for (int it = gw; it < NITEMS; it += NGW) {
        int r = it;
        if (r < I_IN) { p0_transpose_item(a.in[I_WIN], WIN_LD, 72, DM, Win_t, scr, r, lane); continue; } r -= I_IN;
        if (r < I_OUT) { p0_transpose_item(a.in[I_WOUT], DM, 32, DM, Wout_t, scr, r, lane); continue; } r -= I_OUT;
        if (r < I_UP) { p0_transpose_item(a.in[I_WUP], FF, 128, DM, Wup_t, scr, r, lane); continue; } r -= I_UP;
        p0_transpose_item(a.in[I_WDN], DM, 32, FF, Wdn_t, scr, r, lane);
    }
    const int gt = bid * 512 + tid, NGT = G * 512;
    for (int e = gt; e < 256 * 1024; e += NGT) { const int j = e >> 10, k = e & 1023; const float* wr = a.in[I_WIN] + (size_t)k * WIN_LD + 2304; const float* g2 = a.in[I_WGK2] + j;
        float s = 0.f;
#pragma unroll
        for (int r = 0; r < 16; ++r) s += wr[r] * g2[r * 256];
        Win_t[(size_t)(2304 + j) * DM + k] = (bf16)(pkbf(s, 0.f) & 0xffffu); }
    f32x2v* rope = (f32x2v*)(ws + WS_ROPE);
    for (int e = gt; e < 8200 * 32; e += NGT) { const int pidx = e >> 5, i = e & 31; const int pos = pidx < 8192 ? pidx : 16384 + pidx - 8192;
        const double ang = (double)pos * a.inv_freq[i]; const double q = rint(ang * 0.15915494309189535);
        double r = fma(-q, 6.283185307179586, ang); r = fma(-q, 2.4492935982947064e-16, r);
        const float rf = (float)r; rope[e] = (f32x2v){__cosf(rf), __sinf(rf)}; }
    bf16* XN = (bf16*)(ws + WS_XN); const float* g = a.in[I_GMPRE];
    for (int m = gw; m < MR; m += NGW) { const f32x4* xr = (const f32x4*)xrow_ptr(a, m) + lane; f32x4 v[4]; float s = 0.f;
#pragma unroll
        for (int j = 0; j < 4; ++j) { v[j] = xr[64 * j]; s += (v[j].x * v[j].x + v[j].y * v[j].y) + (v[j].z * v[j].z + v[j].w * v[j].w); }
        const float rstd = rsqrtf(wave_sum(s) * (1.f / DM) + EPSN);
        u32x2* o8 = (u32x2*)(XN + (size_t)m * DM) + lane;
#pragma unroll
        for (int j = 0; j < 4; ++j) { const f32x4 gg = ((const f32x4*)g)[lane + 64 * j]; o8[64 * j] = (u32x2){pkbf(v[j].x * rstd * gg.x, v[j].y * rstd * gg.y), pkbf(v[j].z * rstd * gg.z, v[j].w * rstd * gg.w)}; }
    }
}
constexpr int KROW = 144, VROW = 528, LDS_VT = 256 * KROW;
__device__ __forceinline__ void rope_half_row(const bf16* src, const f32x2v* tb, LAS unsigned char* dst, float* outf) {
    const v4u a0 = *(const v4u*)src, a1 = *(const v4u*)(src + 8), b0 = *(const v4u*)(src + 32), b1 = *(const v4u*)(src + 40);
    const unsigned w1[8] = {a0.x, a0.y, a0.z, a0.w, a1.x, a1.y, a1.z, a1.w}, w2[8] = {b0.x, b0.y, b0.z, b0.w, b1.x, b1.y, b1.z, b1.w};
    unsigned r1[8], r2[8];
#pragma unroll
    for (int i = 0; i < 8; ++i) { const f32x2v c0 = tb[2 * i], c1 = tb[2 * i + 1];
        const float x1a = bflo(w1[i]), x1b = bfhi(w1[i]), x2a = bflo(w2[i]), x2b = bfhi(w2[i]);
        const float y1a = x1a * c0.x - x2a * c0.y, y2a = x2a * c0.x + x1a * c0.y, y1b = x1b * c1.x - x2b * c1.y, y2b = x2b * c1.x + x1b * c1.y;
        r1[i] = pkbf(y1a, y1b); r2[i] = pkbf(y2a, y2b);
        if (outf) { outf[2 * i] = y1a; outf[2 * i + 1] = y1b; outf[32 + 2 * i] = y2a; outf[32 + 2 * i + 1] = y2b; } }
    *(LAS v4u*)dst = (v4u){r1[0], r1[1], r1[2], r1[3]}; *(LAS v4u*)(dst + 16) = (v4u){r1[4], r1[5], r1[6], r1[7]};
    *(LAS v4u*)(dst + 64) = (v4u){r2[0], r2[1], r2[2], r2[3]}; *(LAS v4u*)(dst + 80) = (v4u){r2[4], r2[5], r2[6], r2[7]};
}
__device__ __forceinline__ void vt_half_row(const bf16* src, LAS unsigned char* vt_col  , float* outf) {
#pragma unroll
    for (int c = 0; c < 4; ++c) { const v4u w = *(const v4u*)(src + 8 * c); const unsigned ww[4] = {w.x, w.y, w.z, w.w};
#pragma unroll
        for (int i = 0; i < 4; ++i) { const int d = 8 * c + 2 * i;
            *(LAS unsigned short*)(vt_col + d * VROW) = (unsigned short)(ww[i] & 0xffffu); *(LAS unsigned short*)(vt_col + (d + 1) * VROW) = (unsigned short)(ww[i] >> 16);
            if (outf) { outf[d] = bflo(ww[i]); outf[d + 1] = bfhi(ww[i]); } } }
}
__device__ __forceinline__ void load_q_frags(const bf16* src, const f32x2v* tb, bf16x8& q0, bf16x8& q1) {
    const v4u a = *(const v4u*)src, b = *(const v4u*)(src + 32); const unsigned w1[4] = {a.x, a.y, a.z, a.w}, w2[4] = {b.x, b.y, b.z, b.w}; unsigned r1[4], r2[4];
#pragma unroll
    for (int i = 0; i < 4; ++i) { const f32x2v c0 = tb[2 * i], c1 = tb[2 * i + 1];
        const float x1a = bflo(w1[i]), x1b = bfhi(w1[i]), x2a = bflo(w2[i]), x2b = bfhi(w2[i]);
        r1[i] = pkbf(x1a * c0.x - x2a * c0.y, x1b * c1.x - x2b * c1.y); r2[i] = pkbf(x2a * c0.x + x1a * c0.y, x2b * c1.x + x1b * c1.y); }
    q0 = __builtin_bit_cast(bf16x8, (v4u){r1[0], r1[1], r1[2], r1[3]}); q1 = __builtin_bit_cast(bf16x8, (v4u){r2[0], r2[1], r2[2], r2[3]});
}
template <bool SAMPLE> __device__ __forceinline__ void attn_qtile(LAS unsigned char* Ks, LAS unsigned char* Vt, bf16x8 q0, bf16x8 q1, int kt0, float sink2, int l15, int fq, bool first, int qt, bf16* outp) {
    f32x4 s[9];
#pragma unroll
    for (int r = 0; r < 9; ++r) { LAS unsigned char* kp = Ks + ((kt0 + r) * 16 + l15) * KROW + fq * 16;
        const bf16x8 k0 = *(LAS bf16x8*)kp, k1 = *(LAS bf16x8*)(kp + 64);
        f32x4 a = {0.f, 0.f, 0.f, 0.f}; a = mfma16(k0, q0, a); a = mfma16(k1, q1, a); s[r] = a; }
    const float C2 = 0.125f * LOG2E; float mx = -INFINITY;
#pragma unroll
    for (int r = 0; r < 9; ++r)
#pragma unroll
        for (int j = 0; j < 4; ++j) { bool ok;
            if (SAMPLE) { const int kidx = r * 16 + fq * 4 + j, t = l15 & 7; ok = (kidx > t) && (kidx <= t + 128); }
            else { ok = true; if (r == 0) ok = l15 < fq * 4 + j; if (r == 8) ok = l15 >= fq * 4 + j; if (first && (qt + r < 8)) ok = false; }
            const float v = ok ? s[r][j] * C2 : -INFINITY; s[r][j] = v; mx = fmaxf(mx, v); }
    mx = fmaxf(mx, __shfl_xor(mx, 16)); mx = fmaxf(mx, __shfl_xor(mx, 32));
    const float m = fmaxf(mx, sink2); float sum = 0.f;
#pragma unroll
    for (int r = 0; r < 9; ++r)
#pragma unroll
        for (int j = 0; j < 4; ++j) { const float p = __builtin_amdgcn_exp2f(s[r][j] - m); s[r][j] = p; sum += p; }
    sum += __shfl_xor(sum, 16); sum += __shfl_xor(sum, 32);
    const float inv = 1.f / (sum + __builtin_amdgcn_exp2f(sink2 - m));
    f32x4 o[4];
#pragma unroll
    for (int dt = 0; dt < 4; ++dt) o[dt] = (f32x4){0.f, 0.f, 0.f, 0.f};
#pragma unroll
    for (int c = 0; c < 5; ++c) {
        v4u pw; pw.x = pkbf(s[2 * c][0], s[2 * c][1]); pw.y = pkbf(s[2 * c][2], s[2 * c][3]);
        if (c < 4) { pw.z = pkbf(s[2 * c + 1][0], s[2 * c + 1][1]); pw.w = pkbf(s[2 * c + 1][2], s[2 * c + 1][3]); } else { pw.z = 0u; pw.w = 0u; }
        const bf16x8 pf = __builtin_bit_cast(bf16x8, pw);
#pragma unroll
        for (int dt = 0; dt < 4; ++dt) { LAS unsigned char* vp = Vt + (dt * 16 + l15) * VROW + ((kt0 + 2 * c) * 16 + fq * 4) * 2;
            const u32x2 lo = *(LAS u32x2*)vp; u32x2 hi = {0u, 0u}; if (c < 4) hi = *(LAS u32x2*)(vp + 32);
            const bf16x8 vf = __builtin_bit_cast(bf16x8, (v4u){lo.x, lo.y, hi.x, hi.y});
            o[dt] = mfma16(vf, pf, o[dt]); } }
#pragma unroll
    for (int dt = 0; dt < 4; ++dt) *(u32x2*)(outp + dt * 16 + fq * 4) = (u32x2){pkbf(o[dt][0] * inv, o[dt][1] * inv), pkbf(o[dt][2] * inv, o[dt][3] * inv)};
}

__device__ __forceinline__ void attn_prompt_unit(const Args& a, LAS unsigned char* L, int u, int tid, int lane, int wave) {
    const bf16* PROJ = (const bf16*)(a.ws + WS_PROJ); bf16* MIX = (bf16*)(a.ws + WS_MIX); const f32x2v* ROPE = (const f32x2v*)(a.ws + WS_ROPE);
    const int b = u >> 7, n = (u >> 1) & 63, kvh = u & 1;
    LAS unsigned char* Ks = L; LAS unsigned char* Vt = L + LDS_VT;
    __syncthreads();
    { const int key = tid >> 1, hf = tid & 1, kpos = (n - 1) * 128 + key;
      if (kpos >= 0) { const bf16* rowp = PROJ + (size_t)(b * SEQ + kpos) * NPJ; const bool wout = (n == 63) && (key >= 128); const size_t oidx = ((size_t)(b * 128 + key - 128) * 2 + kvh) * 64;
          rope_half_row(rowp + C_K + kvh * 64 + hf * 16, ROPE + (size_t)kpos * 32 + hf * 16, Ks + key * KROW + hf * 32, wout ? a.out + O_KWP + oidx + hf * 16 : nullptr);
          vt_half_row(rowp + C_V + kvh * 64 + hf * 32, Vt + (hf * 32) * VROW + key * 2, wout ? a.out + O_VWP + oidx + hf * 32 : nullptr); }
      else { const v4u z = {0u, 0u, 0u, 0u}; LAS unsigned char* kd = Ks + key * KROW + hf * 32; *(LAS v4u*)kd = z; *(LAS v4u*)(kd + 16) = z; *(LAS v4u*)(kd + 64) = z; *(LAS v4u*)(kd + 80) = z;
#pragma unroll
          for (int d = 0; d < 32; ++d) *(LAS unsigned short*)(Vt + (hf * 32 + d) * VROW + key * 2) = 0; } }
    __syncthreads();
    const int l15 = lane & 15, fq = lane >> 4, g = wave >> 1; const float sink2 = a.in[I_SINK][kvh * 4 + g] * LOG2E;
    for (int i = 0; i < 4; ++i) { const int qt = (wave & 1) * 4 + i, qpos = n * 128 + qt * 16 + l15; const size_t row = (size_t)b * SEQ + qpos;
        bf16x8 q0, q1; load_q_frags(PROJ + row * NPJ + C_Q + (kvh * 4 + g) * 64 + fq * 8, ROPE + (size_t)qpos * 32 + fq * 8, q0, q1);
        attn_qtile<false>(Ks, Vt, q0, q1, qt, sink2, l15, fq, n == 0, qt, MIX + row * DM + (kvh * 4 + g) * 64); }
}

__device__ __forceinline__ void attn_sample_unit(const Args& a, LAS unsigned char* L, int u, int tid, int lane, int wave) {
    const bf16* PROJ = (const bf16*)(a.ws + WS_PROJ); bf16* MIX = (bf16*)(a.ws + WS_MIX); const f32x2v* ROPE = (const f32x2v*)(a.ws + WS_ROPE);
    const int b = u >> 1, kvh = u & 1;
    LAS unsigned char* Ks = L; LAS unsigned char* Vt = L + LDS_VT;
    __syncthreads();
    { const int key = tid >> 2, qd = tid & 3; const size_t ci = ((size_t)(b * 128 + key) * 2 + kvh) * 64 + qd * 16; const f32x4* ck = (const f32x4*)(a.in[I_CK] + ci); const f32x4* cv = (const f32x4*)(a.in[I_CV] + ci);
      f32x4 kv[4], vv[4];
#pragma unroll
      for (int c = 0; c < 4; ++c) { kv[c] = ck[c]; vv[c] = cv[c]; }
      LAS unsigned char* kd = Ks + key * KROW + qd * 32;
      *(LAS v4u*)kd = (v4u){pkbf(kv[0].x, kv[0].y), pkbf(kv[0].z, kv[0].w), pkbf(kv[1].x, kv[1].y), pkbf(kv[1].z, kv[1].w)};
      *(LAS v4u*)(kd + 16) = (v4u){pkbf(kv[2].x, kv[2].y), pkbf(kv[2].z, kv[2].w), pkbf(kv[3].x, kv[3].y), pkbf(kv[3].z, kv[3].w)};
#pragma unroll
      for (int c = 0; c < 4; ++c) { const unsigned p0 = pkbf(vv[c].x, vv[c].y), p1 = pkbf(vv[c].z, vv[c].w); LAS unsigned char* vp = Vt + (qd * 16 + c * 4) * VROW + key * 2;
          *(LAS unsigned short*)vp = (unsigned short)(p0 & 0xffffu); *(LAS unsigned short*)(vp + VROW) = (unsigned short)(p0 >> 16);
          *(LAS unsigned short*)(vp + 2 * VROW) = (unsigned short)(p1 & 0xffffu); *(LAS unsigned short*)(vp + 3 * VROW) = (unsigned short)(p1 >> 16); }
      if (key >= 8) { const size_t oi = ((size_t)(b * 128 + key - 8) * 2 + kvh) * 64 + qd * 16; f32x4* ok = (f32x4*)(a.out + O_KWS + oi); f32x4* ov = (f32x4*)(a.out + O_VWS + oi);
#pragma unroll
          for (int c = 0; c < 4; ++c) { ok[c] = kv[c]; ov[c] = vv[c]; } } }
    if (tid < 16) { const int kk = tid >> 1, hf = tid & 1; const bf16* rowp = PROJ + (size_t)(NPR + b * 8 + kk) * NPJ; const size_t oidx = ((size_t)(b * 128 + 120 + kk) * 2 + kvh) * 64;
        rope_half_row(rowp + C_K + kvh * 64 + hf * 16, ROPE + (size_t)(8192 + kk) * 32 + hf * 16, Ks + (128 + kk) * KROW + hf * 32, a.out + O_KWS + oidx + hf * 16); }
    else if (tid < 32) { const int kk = (tid - 16) >> 1, hf = tid & 1; const bf16* rowp = PROJ + (size_t)(NPR + b * 8 + kk) * NPJ; const size_t oidx = ((size_t)(b * 128 + 120 + kk) * 2 + kvh) * 64;
        vt_half_row(rowp + C_V + kvh * 64 + hf * 32, Vt + (hf * 32) * VROW + (128 + kk) * 2, a.out + O_VWS + oidx + hf * 32); }
    else if (tid >= 64 && tid < 64 + 72) { *(LAS v4u*)(Ks + 136 * KROW + (tid - 64) * 16) = (v4u){0u, 0u, 0u, 0u}; }
    else if (tid >= 192 && tid < 256) { *(LAS v4u*)(Vt + (tid - 192) * VROW + 272) = (v4u){0u, 0u, 0u, 0u}; }
    __syncthreads();
    if (wave < 2) { const int l15 = lane & 15, fq = lane >> 4, g = wave * 2 + (l15 >> 3), t = l15 & 7; const size_t row = (size_t)NPR + b * 8 + t;
        const float sink2 = a.in[I_SINK][kvh * 4 + g] * LOG2E;
        bf16x8 q0, q1; load_q_frags(PROJ + row * NPJ + C_Q + (kvh * 4 + g) * 64 + fq * 8, ROPE + (size_t)(8192 + t) * 32 + fq * 8, q0, q1);
        attn_qtile<true>(Ks, Vt, q0, q1, 0, sink2, l15, fq, false, 0, MIX + row * DM + (kvh * 4 + g) * 64); }
}
constexpr int GROW = 144;
__device__ __forceinline__ void gla_cumsum(const bf16* prow0, int h, const float* b_gk, LAS float* red, int tid, float (&bc)[8], float& blast) {
    const int k = tid & 63, tg = tid >> 6; const float bias = b_gk[h * 64 + k]; float run = 0.f;
#pragma unroll
    for (int i = 0; i < 8; ++i) { const float z = bf2f(prow0[(size_t)(tg * 8 + i) * NPJ + C_Z + h * 64 + k]) + bias; run += logsig16(z); bc[i] = run; }
    red[tg * 64 + k] = run; __syncthreads();
    float pre = 0.f, tot = 0.f;
#pragma unroll
    for (int g = 0; g < 8; ++g) { const float r = red[g * 64 + k]; tot += r; if (g < tg) pre += r; }
#pragma unroll
    for (int i = 0; i < 8; ++i) bc[i] += pre;
    blast = tot;
}
__device__ __forceinline__ void gla_load_vt(const bf16* prow0, int h, LAS unsigned char* VT, int tid) {
    const int v = tid & 127, tq = tid >> 7;
#pragma unroll
    for (int i = 0; i < 8; ++i) { const int t = tq * 16 + 2 * i; const unsigned lo = prow0[(size_t)t * NPJ + C_GV + h * 128 + v], hi = prow0[(size_t)(t + 1) * NPJ + C_GV + h * 128 + v];
        *(LAS unsigned*)(VT + v * GROW + t * 2) = lo | (hi << 16); }
}
__device__ __forceinline__ void gla_local_unit(const Args& a, LAS unsigned char* L, int uid, int tid, int lane, int wave) {
    const int bh = uid >> 7, c = uid & 127, b = bh >> 2, h = bh & 3;
    const bf16* prow0 = (const bf16*)(a.ws + WS_PROJ) + (size_t)(b * SEQ + c * 64) * NPJ;
    LAS unsigned char* KdT = L; LAS unsigned char* VT = L + 64 * GROW; LAS float* red = (LAS float*)(L + 64 * GROW + 128 * GROW);
    __syncthreads();
    float bc[8], blast; gla_cumsum(prow0, h, a.in[I_BGK], red, tid, bc, blast);
    { const int k = tid & 63, tg = tid >> 6; unsigned w[4];
#pragma unroll
      for (int i = 0; i < 4; ++i) { const float k0 = bf2f(prow0[(size_t)(tg * 8 + 2 * i) * NPJ + C_GK + h * 64 + k]) * __expf(blast - bc[2 * i]);
          const float k1 = bf2f(prow0[(size_t)(tg * 8 + 2 * i + 1) * NPJ + C_GK + h * 64 + k]) * __expf(blast - bc[2 * i + 1]); w[i] = pkbf(k0, k1); }
      *(LAS v4u*)(KdT + k * GROW + tg * 16) = (v4u){w[0], w[1], w[2], w[3]};
      if (tg == 0) ((float*)(a.ws + WS_ABLK))[(size_t)uid * 64 + k] = __expf(blast); }
    gla_load_vt(prow0, h, VT, tid);
    __syncthreads();
    const int l15 = lane & 15, fq = lane >> 4, vt = wave;
    bf16x8 vf[2];
#pragma unroll
    for (int ks = 0; ks < 2; ++ks) vf[ks] = *(LAS bf16x8*)(VT + (vt * 16 + l15) * GROW + ks * 64 + fq * 16);
    float* ST = (float*)(a.ws + WS_ST) + (size_t)uid * 8192;
#pragma unroll
    for (int kt = 0; kt < 4; ++kt) { f32x4 acc = {0.f, 0.f, 0.f, 0.f};
#pragma unroll
        for (int ks = 0; ks < 2; ++ks) { const bf16x8 kf = *(LAS bf16x8*)(KdT + (kt * 16 + l15) * GROW + ks * 64 + fq * 16); acc = mfma16(vf[ks], kf, acc); }
#pragma unroll
        for (int j = 0; j < 4; ++j) ST[(vt * 16 + fq * 4 + j) * 64 + kt * 16 + l15] = acc[j]; }
}
__device__ __forceinline__ void gla_scan(const Args& a, int id) {
    const int bh = id >> 13, e = id & 8191, k = e & 63, v = e >> 6;
    float* ST = (float*)(a.ws + WS_ST) + (size_t)bh * 128 * 8192 + e; const float* AB = (const float*)(a.ws + WS_ABLK) + (size_t)bh * 128 * 64 + k;
    float carry = 0.f;
    for (int c0 = 0; c0 < 128; c0 += 8) { float u[8], ab[8];
#pragma unroll
        for (int i = 0; i < 8; ++i) { u[i] = ST[(size_t)(c0 + i) * 8192]; ab[i] = AB[(c0 + i) * 64]; }
#pragma unroll
        for (int i = 0; i < 8; ++i) { ST[(size_t)(c0 + i) * 8192] = carry; carry = ab[i] * carry + u[i]; } }
    a.out[O_GLP + (size_t)bh * 8192 + k * 128 + v] = carry;
}
__device__ __forceinline__ void gla_out_unit(const Args& a, LAS unsigned char* L, int uid, int tid, int lane, int wave) {
    const int bh = uid >> 7, c = uid & 127, b = bh >> 2, h = bh & 3; const size_t row0 = (size_t)b * SEQ + c * 64;
    const bf16* prow0 = (const bf16*)(a.ws + WS_PROJ) + row0 * NPJ;
    LAS unsigned char* Qt = L; LAS unsigned char* Kt = L + 64 * GROW; LAS unsigned char* VT = L + 128 * GROW; LAS float* red = (LAS float*)(L + 256 * GROW); LAS float* nrm = red + 512;
    __syncthreads();
    float bc[8], blast; gla_cumsum(prow0, h, a.in[I_BGK], red, tid, bc, blast);
    { const int k = tid & 63, tg = tid >> 6;
#pragma unroll
      for (int i = 0; i < 8; ++i) { const int t = tg * 8 + i; const float q = bf2f(prow0[(size_t)t * NPJ + C_GQ + h * 64 + k]) * 0.125f * __expf(bc[i]), kk = bf2f(prow0[(size_t)t * NPJ + C_GK + h * 64 + k]) * __expf(-bc[i]);
          *(LAS unsigned short*)(Qt + t * GROW + k * 2) = (unsigned short)(pkbf(q, 0.f) & 0xffffu); *(LAS unsigned short*)(Kt + t * GROW + k * 2) = (unsigned short)(pkbf(kk, 0.f) & 0xffffu); } }
    gla_load_vt(prow0, h, VT, tid);
    __syncthreads();
    const int l15 = lane & 15, fq = lane >> 4, tt = wave & 3, vh = wave >> 2;
    bf16x8 qf[2];
#pragma unroll
    for (int ks = 0; ks < 2; ++ks) qf[ks] = *(LAS bf16x8*)(Qt + (tt * 16 + l15) * GROW + ks * 64 + fq * 16);
    f32x4 at[4];
#pragma unroll
    for (int st = 0; st < 4; ++st) { f32x4 acc = {0.f, 0.f, 0.f, 0.f};
        if (st <= tt) {
#pragma unroll
            for (int ks = 0; ks < 2; ++ks) { const bf16x8 kf = *(LAS bf16x8*)(Kt + (st * 16 + l15) * GROW + ks * 64 + fq * 16); acc = mfma16(kf, qf[ks], acc); }
            if (st == tt) {
#pragma unroll
                for (int j = 0; j < 4; ++j) if (fq * 4 + j > l15) acc[j] = 0.f; } }
        at[st] = acc; }
    bf16x8 pf[2];
#pragma unroll
    for (int cc = 0; cc < 2; ++cc) pf[cc] = __builtin_bit_cast(bf16x8, (v4u){pkbf(at[2 * cc][0], at[2 * cc][1]), pkbf(at[2 * cc][2], at[2 * cc][3]), pkbf(at[2 * cc + 1][0], at[2 * cc + 1][1]), pkbf(at[2 * cc + 1][2], at[2 * cc + 1][3])});
    const float* ST = (const float*)(a.ws + WS_ST) + (size_t)uid * 8192;
    f32x4 acc[4]; float ssq = 0.f;
#pragma unroll
    for (int vi = 0; vi < 4; ++vi) { const int vt = vh * 4 + vi; f32x4 o = {0.f, 0.f, 0.f, 0.f};
#pragma unroll
        for (int ks = 0; ks < 2; ++ks) { const f32x4* sp = (const f32x4*)(ST + (vt * 16 + l15) * 64 + ks * 32 + fq * 8); const f32x4 s0 = sp[0], s1 = sp[1];
            const bf16x8 sf = __builtin_bit_cast(bf16x8, (v4u){pkbf(s0.x, s0.y), pkbf(s0.z, s0.w), pkbf(s1.x, s1.y), pkbf(s1.z, s1.w)}); o = mfma16(sf, qf[ks], o); }
#pragma unroll
        for (int cc = 0; cc < 2; ++cc) if (2 * cc <= tt) { LAS unsigned char* vp = VT + (vt * 16 + l15) * GROW + (cc * 32 + fq * 4) * 2; const u32x2 lo = *(LAS u32x2*)vp, hi = *(LAS u32x2*)(vp + 32);
            o = mfma16(__builtin_bit_cast(bf16x8, (v4u){lo.x, lo.y, hi.x, hi.y}), pf[cc], o); }
        acc[vi] = o; ssq += (o[0] * o[0] + o[1] * o[1]) + (o[2] * o[2] + o[3] * o[3]); }
    ssq += __shfl_xor(ssq, 16); ssq += __shfl_xor(ssq, 32);
    if (fq == 0) nrm[vh * 64 + tt * 16 + l15] = ssq;
    __syncthreads();
    const int t = tt * 16 + l15; const float rstd = rsqrtf((nrm[t] + nrm[64 + t]) * (1.f / 128.f) + EPSN);
    bf16* MIX = (bf16*)(a.ws + WS_MIX) + (row0 + t) * DM + 512 + h * 128; const bf16* grp = prow0 + (size_t)t * NPJ + C_GR + h * 128; const float* gg = a.in[I_GGLA];
#pragma unroll
    for (int vi = 0; vi < 4; ++vi) { const int v0 = (vh * 4 + vi) * 16 + fq * 4; const u32x2 gw = *(const u32x2*)(grp + v0); const f32x4 g4 = *(const f32x4*)(gg + v0);
        const float r0 = bflo(gw.x), r1 = bfhi(gw.x), r2 = bflo(gw.y), r3 = bfhi(gw.y);
        const float o0 = acc[vi][0] * rstd * g4.x * (r0 / (1.f + __expf(-r0))), o1 = acc[vi][1] * rstd * g4.y * (r1 / (1.f + __expf(-r1)));
        const float o2 = acc[vi][2] * rstd * g4.z * (r2 / (1.f + __expf(-r2))), o3 = acc[vi][3] * rstd * g4.w * (r3 / (1.f + __expf(-r3)));
        *(u32x2*)(MIX + v0) = (u32x2){pkbf(o0, o1), pkbf(o2, o3)}; }
}
__device__ __forceinline__ void gla_sample_unit(const Args& a, LAS unsigned char* L, int u, int tid, int lane, int wave) {
    const int b = u >> 2, h = u & 3; const size_t row0 = (size_t)NPR + b * 8;
    const bf16* prow0 = (const bf16*)(a.ws + WS_PROJ) + row0 * NPJ;
    LAS float* BS = (LAS float*)L; LAS float* QD = BS + 512; LAS float* KD = QD + 512; LAS float* KE = KD + 512; LAS float* AB = KE + 512; LAS float* AT = AB + 64; LAS float* OP = AT + 64; LAS float* NR = OP + 4096;
    __syncthreads();
    { const int k = tid & 63, t = tid >> 6; BS[t * 64 + k] = logsig16(bf2f(prow0[(size_t)t * NPJ + C_Z + h * 64 + k]) + a.in[I_BGK][h * 64 + k]); }
    __syncthreads();
    { const int k = tid & 63, t = tid >> 6; float bt = 0.f, bl = 0.f;
#pragma unroll
      for (int i = 0; i < 8; ++i) { const float l = BS[i * 64 + k]; bl += l; if (i <= t) bt += l; }
      const float q = bf2f(prow0[(size_t)t * NPJ + C_GQ + h * 64 + k]) * 0.125f, kk = bf2f(prow0[(size_t)t * NPJ + C_GK + h * 64 + k]);
      QD[t * 64 + k] = q * __expf(bt); KD[t * 64 + k] = kk * __expf(bl - bt); KE[t * 64 + k] = kk * __expf(-bt); if (t == 0) AB[k] = __expf(bl); }
    __syncthreads();
    if (tid < 64) { const int t = tid >> 3, s = tid & 7; float acc = 0.f;
        if (s <= t) { for (int k = 0; k < 64; ++k) acc += QD[t * 64 + k] * KE[s * 64 + k]; }
        AT[t * 8 + s] = acc; }
    const int v = tid & 127, kq = tid >> 7;
    float vv[8], acc[8];
#pragma unroll
    for (int t = 0; t < 8; ++t) { vv[t] = bf2f(prow0[(size_t)t * NPJ + C_GV + h * 128 + v]); acc[t] = 0.f; }
    const float* S0 = a.in[I_SG] + (size_t)u * 8192; float* SN = a.out + O_GLS + (size_t)u * 8192;
#pragma unroll 4
    for (int kk = 0; kk < 16; ++kk) { const int k = kq * 16 + kk; const float s0 = S0[k * 128 + v]; float sn = AB[k] * s0;
#pragma unroll
        for (int t = 0; t < 8; ++t) { acc[t] += QD[t * 64 + k] * s0; sn += KD[t * 64 + k] * vv[t]; }
        SN[k * 128 + v] = sn; }
#pragma unroll
    for (int t = 0; t < 8; ++t) OP[(kq * 8 + t) * 128 + v] = acc[t];
    __syncthreads();
    float o[2];
#pragma unroll
    for (int ti = 0; ti < 2; ++ti) { const int t = kq * 2 + ti; float x = (OP[t * 128 + v] + OP[(8 + t) * 128 + v]) + (OP[(16 + t) * 128 + v] + OP[(24 + t) * 128 + v]);
#pragma unroll
        for (int s = 0; s < 8; ++s) x += AT[t * 8 + s] * vv[s];
        o[ti] = x; const float ss = wave_sum(x * x); if (lane == 0) NR[wave * 2 + ti] = ss; }
    __syncthreads();
    bf16* MIX = (bf16*)(a.ws + WS_MIX);
#pragma unroll
    for (int ti = 0; ti < 2; ++ti) { const int t = kq * 2 + ti; const float rstd = rsqrtf((NR[(kq * 2) * 2 + ti] + NR[(kq * 2 + 1) * 2 + ti]) * (1.f / 128.f) + EPSN);
        const float r = bf2f(prow0[(size_t)t * NPJ + C_GR + h * 128 + v]);
        MIX[(row0 + t) * DM + 512 + h * 128 + v] = (bf16)(pkbf(o[ti] * rstd * a.in[I_GGLA][v] * (r / (1.f + __expf(-r))), 0.f) & 0xffffu); }
}
__device__ __forceinline__ void phase6(const Args& a, int G, int bid, int lane, int wave) {
    const int gw = bid * 8 + wave, NGW = G * 8; const bf16* MO = (const bf16*)(a.ws + WS_MIXOUT); const float* SS = (const float*)(a.ws + WS_SS); bf16* XN = (bf16*)(a.ws + WS_XN);
    const f32x4* g1 = (const f32x4*)a.in[I_GMPOST]; const f32x4* g2 = (const f32x4*)a.in[I_GFPRE];
    for (int m = gw; m < MR; m += NGW) { const f32x4* xr = (const f32x4*)xrow_ptr(a, m) + lane; const u32x2* mo = (const u32x2*)(MO + (size_t)m * DM) + lane;
        const float rstd1 = rsqrtf(wave_sum(SS[(size_t)m * 16 + (lane & 15)]) * (0.25f / DM) + EPSN);
        f32x4 x1[4]; float s = 0.f;
#pragma unroll
        for (int j = 0; j < 4; ++j) { const f32x4 x = xr[64 * j], g = g1[lane + 64 * j]; const u32x2 w = mo[64 * j];
            x1[j].x = x.x + bflo(w.x) * rstd1 * g.x; x1[j].y = x.y + bfhi(w.x) * rstd1 * g.y; x1[j].z = x.z + bflo(w.y) * rstd1 * g.z; x1[j].w = x.w + bfhi(w.y) * rstd1 * g.w;
            s += (x1[j].x * x1[j].x + x1[j].y * x1[j].y) + (x1[j].z * x1[j].z + x1[j].w * x1[j].w); }
        const float rstd2 = rsqrtf(wave_sum(s) * (1.f / DM) + EPSN);
        f32x4* yo = (f32x4*)(a.out + (size_t)m * DM) + lane; u32x2* o8 = (u32x2*)(XN + (size_t)m * DM) + lane;
#pragma unroll
        for (int j = 0; j < 4; ++j) { const f32x4 g = g2[lane + 64 * j]; yo[64 * j] = x1[j];
            o8[64 * j] = (u32x2){pkbf(x1[j].x * rstd2 * g.x, x1[j].y * rstd2 * g.y), pkbf(x1[j].z * rstd2 * g.z, x1[j].w * rstd2 * g.w)}; } }
}
__device__ __forceinline__ void phase9(const Args& a, int G, int bid, int lane, int wave) {
    const int gw = bid * 8 + wave, NGW = G * 8; const bf16* F = (const bf16*)(a.ws + WS_F); const float* SS = (const float*)(a.ws + WS_SS); const f32x4* g1 = (const f32x4*)a.in[I_GFPOST];
    for (int m = gw; m < MR; m += NGW) { f32x4* yo = (f32x4*)(a.out + (size_t)m * DM) + lane; const u32x2* fo = (const u32x2*)(F + (size_t)m * DM) + lane;
        const float rstd = rsqrtf(wave_sum(SS[(size_t)m * 16 + (lane & 15)]) * (0.25f / DM) + EPSN);
#pragma unroll
        for (int j = 0; j < 4; ++j) { f32x4 x = yo[64 * j]; const f32x4 g = g1[lane + 64 * j]; const u32x2 w = fo[64 * j];
            x.x += bflo(w.x) * rstd * g.x; x.y += bfhi(w.x) * rstd * g.y; x.z += bflo(w.y) * rstd * g.z; x.w += bfhi(w.y) * rstd * g.w; yo[64 * j] = x; } }
}
__global__ void __launch_bounds__(512, 2) mk_fwd(Args args) {
    extern __shared__ __attribute__((aligned(16))) unsigned char lds[];
    LAS unsigned char* L = (LAS unsigned char*)lds;
    volatile LAS unsigned* MISC = (volatile LAS unsigned*)(L + MISC_OFF);
    const int tid = threadIdx.x, lane = tid & 63, wave = __builtin_amdgcn_readfirstlane(tid >> 6);
    const int G = gridDim.x, bid = blockIdx.x;
    if (tid < 64) MISC[tid] = 0u;
    __syncthreads();
    if (args.never) cooperative_groups::this_grid().sync();
    unsigned* barw = (unsigned*)(args.ws + WS_CTL) + CW_BAR;
    XcdBarrier bar; bar.bar = barw; bar.x = 0; bar.st = nullptr;
    if (args.use_bar) bar = xcd_barrier_post(barw, MISC + 8);
    const int lo = args.ph_lo, hi = args.ph_hi;
#define IN(k) (lo <= (k) && (k) < hi)
#define SEAM(k) do { if (IN(k) && IN((k) + 1)) xcd_barrier(bar); } while (0)
    unsigned char* ws = args.ws;
    if (IN(0)) { phase0(args, L, G, bid, tid, lane, wave); SEAM(0); }
    if (IN(1)) { pg8::Gemm g{(const bf16*)(ws + WS_XN), (const bf16*)(ws + WS_WIN), MR, NPJ, DM}; pg8::StaticOrder S; S.init(MR, NPJ, G, bid);
        pg8::EpiMk<0, false> E{(bf16*)(ws + WS_PROJ), NPJ, nullptr};
        pg8::gemm_phase<pg8::EpiMk<0, false>, pg8::StaticOrder, true, true>(L, g, S, E); SEAM(1); }
    if (IN(2)) {
        for (int u = bid; u < 256; u += G) attn_prompt_unit(args, L, u, tid, lane, wave);
        for (int u = bid; u < 256; u += G) attn_sample_unit(args, L, u, tid, lane, wave);
        for (int u = bid; u < 1024; u += G) gla_local_unit(args, L, u, tid, lane, wave);
        SEAM(2); }
    if (IN(3)) { const int gs = G >> 1;
        if (bid < gs) { for (int id = bid * 512 + tid; id < 65536; id += gs * 512) gla_scan(args, id); }
        else { for (int u = bid - gs; u < 512; u += G - gs) gla_sample_unit(args, L, u, tid, lane, wave); }
        SEAM(3); }
    if (IN(4)) { for (int u = bid; u < 1024; u += G) gla_out_unit(args, L, u, tid, lane, wave); SEAM(4); }
    if (IN(5)) { pg8::Gemm g{(const bf16*)(ws + WS_MIX), (const bf16*)(ws + WS_WOUT), MR, DM, DM}; pg8::StaticOrder S; S.init(MR, DM, G, bid);
        pg8::EpiMk<0, true> E{(bf16*)(ws + WS_MIXOUT), DM, (float*)(ws + WS_SS)};
        pg8::gemm_phase<pg8::EpiMk<0, true>, pg8::StaticOrder, true, true>(L, g, S, E); SEAM(5); }
    if (IN(6)) { phase6(args, G, bid, lane, wave); SEAM(6); }
    if (IN(7)) { pg8::Gemm g{(const bf16*)(ws + WS_XN), (const bf16*)(ws + WS_WUP), MR, FF, DM}; pg8::StaticOrder S; S.init(MR, FF, G, bid);
        pg8::EpiMk<1, false> E{(bf16*)(ws + WS_U), FF, nullptr};
        pg8::gemm_phase<pg8::EpiMk<1, false>, pg8::StaticOrder, true, true>(L, g, S, E); SEAM(7); }
    if (IN(8)) { pg8::Gemm g{(const bf16*)(ws + WS_U), (const bf16*)(ws + WS_WDN), MR, DM, FF}; pg8::StaticOrder S; S.init(MR, DM, G, bid);
        pg8::EpiMk<0, true> E{(bf16*)(ws + WS_F), DM, (float*)(ws + WS_SS)};
        pg8::gemm_phase<pg8::EpiMk<0, true>, pg8::StaticOrder, true, true>(L, g, S, E); SEAM(8); }
    if (IN(9)) { phase9(args, G, bid, lane, wave); }
#undef IN
#undef SEAM
}

extern "C" void kernel_launch(void* const* d_in, const int* in_sizes, int n_in, void* d_out, int out_size, void* d_ws, size_t ws_size, hipStream_t stream) {
    static int grid = 0;
    if (grid == 0) {
        if (n_in != 17 || ws_size < WS_END) { fprintf(stderr, "kernel_launch: unexpected n_in %d / ws %zu\n", n_in, ws_size); grid = -1; return; }
        int dev = 0, cus = 0, per_cu = 0;
        if (hipGetDevice(&dev) != hipSuccess || hipDeviceGetAttribute(&cus, hipDeviceAttributeMultiprocessorCount, dev) != hipSuccess) { grid = -1; return; }
        if (hipFuncSetAttribute((const void*)mk_fwd, hipFuncAttributeMaxDynamicSharedMemorySize, LDS_BYTES) != hipSuccess) { fprintf(stderr, "kernel_launch: hipFuncSetAttribute failed\n"); grid = -1; return; }
        if (hipOccupancyMaxActiveBlocksPerMultiprocessor(&per_cu, (const void*)mk_fwd, 512, LDS_BYTES) != hipSuccess || per_cu < 1) { fprintf(stderr, "kernel_launch: occupancy query says %d\n", per_cu); per_cu = 1; }
        (void)hipGetLastError();
        grid = cus * 1;
        if (grid & 1) grid -= 1;
    }
    if (grid < 0) return;
    (void)hipMemsetAsync((char*)d_ws + WS_CTL, 0, CTL_ZERO_BYTES, stream);
    Args a{};
    for (int i = 0; i < 17; ++i) a.in[i] = (const float*)d_in[i];
    a.out = (float*)d_out; a.ws = (unsigned char*)d_ws;
    for (int i = 0; i < 32; ++i) a.inv_freq[i] = pow(10000.0, -(double)i / 32.0);
    a.never = 0;
#if MK_N_LAUNCHES == 1
    a.ph_lo = 0; a.ph_hi = NPH; a.use_bar = 1;
    void* kargs[] = {&a};
    hipError_t e = hipLaunchCooperativeKernel((const void*)mk_fwd, dim3(grid), dim3(512), kargs, LDS_BYTES, stream);
    if (e != hipSuccess) fprintf(stderr, "kernel_launch: cooperative launch failed: %s (grid %d)\n", hipGetErrorString(e), grid);
#else
    a.use_bar = 0;
    for (int p = 0; p < NPH; ++p) { a.ph_lo = p; a.ph_hi = p + 1; hipLaunchKernelGGL(mk_fwd, dim3(grid), dim3(512), LDS_BYTES, stream, a); }
#endif
}
```

```cpp
#include <hip/hip_cooperative_groups.h>
#include <cmath>
#include <hip/hip_runtime.h>
#include <cstdio>
#include <cstdint>
namespace pg8 {
#define PG8_LAS __attribute__((address_space(3)))
typedef unsigned short bf16_t;
typedef short bf16x8 __attribute__((ext_vector_type(8)));
typedef float f32x4 __attribute__((ext_vector_type(4)));
typedef unsigned u32x4 __attribute__((ext_vector_type(4)));
constexpr int BM = 256, BK = 64, HALF = 128, HTB = HALF * BK * 2  , STAGE_BYTES = 8 * HTB, NXCD = 8, WGM = 8;

__host__ __device__ __forceinline__ int lds_byte(int r, int c) { const int st = (r >> 4) * 2 + (c >> 5), rr = r & 15, cc = c & 31, ob = rr * 64 + cc * 2; return st * 1024 + (ob ^ (((ob >> 9) & 1) << 5)); }
__host__ __device__ __forceinline__ void stage_rc(int b, int& R, int& C) { const int st = b / 1024, sb = b % 1024, swz = sb ^ (((sb >> 9) & 1) << 5); R = (st >> 1) * 16 + swz / 64; C = (st & 1) * 32 + (swz % 64) / 2; }
__host__ __device__ __forceinline__ int perm32(int rho) { const int n = rho >> 4, i = rho & 15; return 8 * (i >> 2) + 4 * n + (i & 3); }

struct Unit { int pm, pn; };
struct Gemm { const bf16_t* A; const bf16_t* Bt; int M, N, K; };

struct StaticOrder {
    int nM, nN, nwg, G, c;
    __host__ __device__ void init(int M, int N, int G_, int c_) { nM = M / BM; nN = N / BM; nwg = nM * nN; G = G_; c = c_; }
    __host__ __device__ bool next(int i, Unit& u) const {
        const long L = (long)i * G + c; if (L >= nwg) return false;
        int wgid = (int)L; { const int q = nwg / NXCD, r = nwg % NXCD, xcd = wgid % NXCD, off = wgid / NXCD; wgid = (xcd < r ? xcd * (q + 1) : r * (q + 1) + (xcd - r) * q) + off; }
        const int nig = WGM * nN, gid = wgid / nig, fm = gid * WGM, gsz = (nM - fm) < WGM ? (nM - fm) : WGM;
        u.pm = fm + ((wgid % nig) % gsz); u.pn = (wgid % nig) / gsz; return true;
    }
    __device__ __forceinline__ void a_ready(const Unit&) const {}
    __device__ __forceinline__ void done(const Unit&) const {}
};

__device__ __forceinline__ unsigned cvt_pk_bf16(float lo, float hi) { unsigned r; asm volatile("v_cvt_pk_bf16_f32 %0, %1, %2" : "=v"(r) : "v"(lo), "v"(hi)); return r; }
typedef float f32x2 __attribute__((ext_vector_type(2)));
template <int ACT, bool STATS> struct EpiMk {
    static constexpr bool PERM = true, AFTER_DRAIN = false;
    bf16_t* O; int ldc; float* ss;
    __device__ __forceinline__ void operator()(const f32x4 (&acc)[2][2][4][2], const Unit& u, int wr, int wc, int fr, int fq) const {
        const int row0 = u.pm * BM + wr * 64 + fr; const int col0 = u.pn * BM + wc * 32 + 8 * fq;
#pragma unroll
        for (int ai = 0; ai < 2; ++ai)
#pragma unroll
            for (int m = 0; m < 4; ++m) { const int row = row0 + ai * HALF + m * 16; bf16_t* rowp = O + (size_t)row * ldc + col0; float s = 0.f;
#pragma unroll
                for (int bj = 0; bj < 2; ++bj) { f32x4 v0 = acc[ai][bj][m][0], v1 = acc[ai][bj][m][1];
                    if (ACT == 1) {
#pragma unroll
                        for (int e = 0; e < 4; ++e) { const float a = fmaxf(v0[e], 0.f), b = fmaxf(v1[e], 0.f); v0[e] = a * a; v1[e] = b * b; } }
                    if (STATS) s += (v0[0] * v0[0] + v0[1] * v0[1]) + (v0[2] * v0[2] + v0[3] * v0[3]) + (v1[0] * v1[0] + v1[1] * v1[1]) + (v1[2] * v1[2] + v1[3] * v1[3]);
                    u32x4 w; w.x = cvt_pk_bf16(v0[0], v0[1]); w.y = cvt_pk_bf16(v0[2], v0[3]); w.z = cvt_pk_bf16(v1[0], v1[1]); w.w = cvt_pk_bf16(v1[2], v1[3]);
                    *(u32x4*)(rowp + bj * HALF) = w; }
                if (STATS) { s += __shfl_xor(s, 16); s += __shfl_xor(s, 32); if (fq == 0) ss[(size_t)row * 16 + u.pn * 4 + wc] = s; } }
    }
};

template <class Epi, class Sched, bool ALIGN_EPI = false, bool SP2 = false>
__device__ __forceinline__ void gemm_phase(PG8_LAS unsigned char* lds, const Gemm g, const Sched& S, const Epi& E) {
    const int tid = threadIdx.x, wid = __builtin_amdgcn_readfirstlane(tid >> 6), lane = tid & 63, wr = wid >> 2, wc = wid & 3, fr = lane & 15, fq = lane >> 4;
    const int K = g.K, nt = K / BK;
    unsigned voffA[2], voffB[2];
#pragma unroll
    for (int i = 0; i < 2; ++i) { int R, C; stage_rc(tid * 16 + i * 8192, R, C); const int Rb = Epi::PERM ? ((R & ~31) + perm32(R & 31)) : R;
        voffA[i] = (unsigned)(R * K + C) * 2u; voffB[i] = (unsigned)(Rb * K + C) * 2u; }
    const size_t kstep = (size_t)(BK * 2);
    const size_t hstep = (size_t)HALF * K * 2;
    const size_t tstep = 2 * hstep;
    const unsigned ldsw = (unsigned)wid * 1024u;
    const int aoff = lds_byte(wr * 64 + fr, fq * 8), boff = lds_byte(wc * 32 + fr, fq * 8);
#define PG8_SA(b, h) (((b) * 2 + (h)) * HTB)
#define PG8_SB(b, h) ((4 + (b) * 2 + (h)) * HTB)
#define PG8_STAGE(bufoff, gbase, voff) do { _Pragma("unroll") for (int _i = 0; _i < 2; ++_i) \
        __builtin_amdgcn_global_load_lds((const unsigned*)((const char*)(gbase) + (voff)[_i]), (PG8_LAS unsigned*)(lds + (bufoff) + ldsw + _i * 8192), 16, 0, 0); } while (0)
#define PG8_LDA(dst, b, h) do { _Pragma("unroll") for (int m = 0; m < 4; ++m) _Pragma("unroll") for (int k = 0; k < 2; ++k) dst[m][k] = *(const PG8_LAS bf16x8*)(lds + PG8_SA(b, h) + aoff + m * 2048 + k * 1024); } while (0)
#define PG8_LDB(dst, b, h) do { _Pragma("unroll") for (int n = 0; n < 2; ++n) _Pragma("unroll") for (int k = 0; k < 2; ++k) dst[n][k] = *(const PG8_LAS bf16x8*)(lds + PG8_SB(b, h) + boff + n * 2048 + k * 1024); } while (0)
#define PG8_MMA(ai, bj, At, Bt) do { __builtin_amdgcn_s_setprio(1); _Pragma("unroll") for (int m = 0; m < 4; ++m) _Pragma("unroll") for (int n = 0; n < 2; ++n) _Pragma("unroll") for (int k = 0; k < 2; ++k) \
        acc[ai][bj][m][n] = __builtin_amdgcn_mfma_f32_16x16x32_bf16(Bt[n][k], At[m][k], acc[ai][bj][m][n], 0, 0, 0); __builtin_amdgcn_s_setprio(0); } while (0)
#define PG8_WAIT_V(n) asm volatile("s_waitcnt vmcnt(" #n ")" ::: "memory")
#define PG8_WAIT_L(n) asm volatile("s_waitcnt lgkmcnt(" #n ")" ::: "memory")
#define PG8_BAR __builtin_amdgcn_s_barrier()
#define PG8_SCHED __builtin_amdgcn_sched_barrier(0)
    Unit cur, nxt; int ui = 0;
    if (!S.next(0, cur)) return;
    f32x4 acc[2][2][4][2];
#pragma unroll
    for (int a = 0; a < 2; ++a)
#pragma unroll
        for (int b = 0; b < 2; ++b)
#pragma unroll
            for (int m = 0; m < 4; ++m)
#pragma unroll
                for (int n = 0; n < 2; ++n) acc[a][b][m][n] = (f32x4){0.f, 0.f, 0.f, 0.f};
    bf16x8 At[4][2], B0[2][2], B1[2][2];
    const char* cA = (const char*)g.A + (size_t)cur.pm * tstep; const char* cB = (const char*)g.Bt + (size_t)cur.pn * tstep;
    S.a_ready(cur);
    if constexpr (SP2) {
        PG8_STAGE(PG8_SB(0, 0), cB, voffB); PG8_STAGE(PG8_SB(0, 1), cB + hstep, voffB); PG8_STAGE(PG8_SA(0, 0), cA, voffA); PG8_STAGE(PG8_SA(0, 1), cA + hstep, voffA);
        if (wr == 1) PG8_BAR;
        PG8_WAIT_V(2); PG8_BAR;
        PG8_STAGE(PG8_SB(1, 0), cB + kstep, voffB); PG8_STAGE(PG8_SA(1, 0), cA + kstep, voffA); PG8_STAGE(PG8_SB(1, 1), cB + hstep + kstep, voffB);
        PG8_WAIT_V(6); PG8_BAR;
    } else {
        PG8_STAGE(PG8_SB(0, 0), cB, voffB); PG8_STAGE(PG8_SA(0, 0), cA, voffA); PG8_STAGE(PG8_SB(0, 1), cB + hstep, voffB); PG8_STAGE(PG8_SA(0, 1), cA + hstep, voffA);
        if (wr == 1) PG8_BAR;
        PG8_WAIT_V(4); PG8_BAR;
        PG8_STAGE(PG8_SB(1, 0), cB + kstep, voffB); PG8_STAGE(PG8_SA(1, 0), cA + kstep, voffA); PG8_STAGE(PG8_SB(1, 1), cB + hstep + kstep, voffB);
        PG8_WAIT_V(6); PG8_BAR;
    }
    for (;;) {
        const bool has_next = S.next(ui + 1, nxt);
        const char* nA = has_next ? (const char*)g.A + (size_t)nxt.pm * tstep : cA; const char* nB = has_next ? (const char*)g.Bt + (size_t)nxt.pn * tstep : cB;
        for (int t = 0; t < nt; t += 2) {
            const bool last = (t == nt - 2);
            const char* a1 = cA + (size_t)(t + 1) * kstep;
            const char* a2 = last ? nA : cA + (size_t)(t + 2) * kstep; const char* b2 = last ? nB : cB + (size_t)(t + 2) * kstep;
            const char* a3 = a2 + kstep; const char* b3 = b2 + kstep;
            if (last && has_next) S.a_ready(nxt);
            if constexpr (SP2) {
            PG8_LDB(B0, 0, 0); PG8_LDB(B1, 0, 1); PG8_SCHED; PG8_LDA(At, 0, 0); PG8_STAGE(PG8_SA(1, 1), a1 + hstep, voffA);
            PG8_WAIT_V(8); PG8_WAIT_L(0); PG8_BAR; PG8_MMA(0, 0, At, B0); PG8_MMA(0, 1, At, B1); PG8_BAR; PG8_SCHED;
            PG8_LDA(At, 0, 1); PG8_STAGE(PG8_SB(0, 0), b2, voffB); PG8_STAGE(PG8_SB(0, 1), b2 + hstep, voffB); PG8_STAGE(PG8_SA(0, 0), a2, voffA);
            PG8_WAIT_V(8); PG8_WAIT_L(0); PG8_BAR; PG8_MMA(1, 0, At, B0); PG8_MMA(1, 1, At, B1); PG8_BAR; PG8_SCHED;
            PG8_LDB(B0, 1, 0); PG8_LDB(B1, 1, 1); PG8_SCHED; PG8_LDA(At, 1, 0); PG8_STAGE(PG8_SA(0, 1), a2 + hstep, voffA);
            PG8_WAIT_V(8); PG8_WAIT_L(0); PG8_BAR; PG8_MMA(0, 0, At, B0); PG8_MMA(0, 1, At, B1); PG8_BAR; PG8_SCHED;
            PG8_LDA(At, 1, 1); PG8_STAGE(PG8_SB(1, 0), b3, voffB); PG8_STAGE(PG8_SB(1, 1), b3 + hstep, voffB); PG8_STAGE(PG8_SA(1, 0), a3, voffA);
            PG8_WAIT_V(8); PG8_WAIT_L(0); PG8_BAR; PG8_MMA(1, 0, At, B0); PG8_MMA(1, 1, At, B1); PG8_BAR; PG8_SCHED;
            } else {
            PG8_LDB(B0, 0, 0); PG8_SCHED; PG8_LDA(At, 0, 0); PG8_STAGE(PG8_SA(1, 1), a1 + hstep, voffA);
            PG8_WAIT_L(8); PG8_BAR; PG8_WAIT_L(0); PG8_MMA(0, 0, At, B0); PG8_BAR; PG8_SCHED;
            PG8_LDB(B1, 0, 1); PG8_STAGE(PG8_SB(0, 0), b2, voffB);
            PG8_BAR; PG8_WAIT_L(0); PG8_MMA(0, 1, At, B1); PG8_BAR;
            PG8_LDA(At, 0, 1); PG8_STAGE(PG8_SA(0, 0), a2, voffA);
            PG8_BAR; PG8_WAIT_L(0); PG8_MMA(1, 0, At, B0); PG8_BAR; PG8_SCHED;
            PG8_STAGE(PG8_SB(0, 1), b2 + hstep, voffB);
            PG8_WAIT_V(6); PG8_BAR; PG8_MMA(1, 1, At, B1); PG8_BAR;
            PG8_LDB(B0, 1, 0); PG8_SCHED; PG8_LDA(At, 1, 0); PG8_STAGE(PG8_SA(0, 1), a2 + hstep, voffA);
            PG8_WAIT_L(8); PG8_BAR; PG8_WAIT_L(0); PG8_MMA(0, 0, At, B0); PG8_BAR; PG8_SCHED;
            PG8_LDB(B1, 1, 1); PG8_STAGE(PG8_SB(1, 0), b3, voffB);
            PG8_BAR; PG8_WAIT_L(0); PG8_MMA(0, 1, At, B1); PG8_BAR;
            PG8_LDA(At, 1, 1); PG8_STAGE(PG8_SA(1, 0), a3, voffA);
            PG8_BAR; PG8_WAIT_L(0); PG8_MMA(1, 0, At, B0); PG8_BAR; PG8_SCHED;
            PG8_STAGE(PG8_SB(1, 1), b3 + hstep, voffB);
            PG8_WAIT_V(6); PG8_BAR; PG8_MMA(1, 1, At, B1); PG8_BAR;
            }
        }
        if constexpr (ALIGN_EPI) { if (wr == 0) PG8_BAR; }
        if constexpr (!Epi::AFTER_DRAIN) { E(acc, cur, wr, wc, fr, fq); S.done(cur); }
        if (!has_next) break;
#pragma unroll
        for (int a = 0; a < 2; ++a)
#pragma unroll
            for (int b = 0; b < 2; ++b)
#pragma unroll
                for (int m = 0; m < 4; ++m)
#pragma unroll
                    for (int n = 0; n < 2; ++n) acc[a][b][m][n] = (f32x4){0.f, 0.f, 0.f, 0.f};
        cur = nxt; cA = nA; cB = nB; ++ui;
        if constexpr (ALIGN_EPI) { if (wr == 1) PG8_BAR; }
    }
    PG8_WAIT_V(0);
    if constexpr (!ALIGN_EPI) { if (wr == 0) PG8_BAR; }
    PG8_BAR;
    if constexpr (Epi::AFTER_DRAIN) { E.fused(acc, cur, wr, wc, fr, fq, lds, wid, lane); S.done(cur); }
#undef PG8_SA
#undef PG8_SB
#undef PG8_STAGE
#undef PG8_LDA
#undef PG8_LDB
#undef PG8_MMA
#undef PG8_WAIT_V
#undef PG8_WAIT_L
#undef PG8_BAR
#undef PG8_SCHED
}
}
#define GAS __attribute__((address_space(1)))
#define LAS __attribute__((address_space(3)))
typedef unsigned short bf16;
typedef unsigned v4u __attribute__((ext_vector_type(4)));
typedef float f32x4 __attribute__((ext_vector_type(4)));
typedef short bf16x8 __attribute__((ext_vector_type(8)));
typedef GAS unsigned gu32;
typedef GAS unsigned long long gu64;
#define RLX_AGENT __ATOMIC_RELAXED, __HIP_MEMORY_SCOPE_AGENT
#define LDS_WAIT() asm volatile("s_waitcnt lgkmcnt(0)" ::: "memory")
#define VM_WAIT() asm volatile("s_waitcnt vmcnt(0)" ::: "memory")
__device__ __forceinline__ unsigned long long rt() { return __builtin_amdgcn_s_memrealtime(); }
__device__ __forceinline__ unsigned f2bf(float f) { unsigned u = __builtin_bit_cast(unsigned, f); return (u + 0x7fffu + ((u >> 16) & 1u)) >> 16; }
__device__ __forceinline__ unsigned pk2(float lo, float hi) { return f2bf(lo) | (f2bf(hi) << 16); }

#define XB_TMO      128
#define XB_XCNT(j)  (256  + 64 * (j))
#define XB_XSUB(j)  (1280 + 64 * (j))
#define XB_XGEN(j)  (2304 + 64 * (j))
#define XB_TOP      3328
#define XB_TOPGEN   3392
#define XCD_BAR_WORDS 3456
#define XB_SPIN_CAP (1u << 18)

__device__ __forceinline__ unsigned xb_ld(unsigned* p)              { return __hip_atomic_load(p, __ATOMIC_RELAXED, __HIP_MEMORY_SCOPE_AGENT); }
__device__ __forceinline__ unsigned xb_add(unsigned* p, unsigned v) { return __hip_atomic_fetch_add(p, v, __ATOMIC_RELAXED, __HIP_MEMORY_SCOPE_AGENT); }
__device__ __forceinline__ unsigned xb_xcc_id() { return (unsigned)__builtin_amdgcn_s_getreg((3 << 11) | 20) & 0xFu; }
#define XB_SPIN(cond, bar) do { unsigned _sp = 0; while (cond) { __builtin_amdgcn_s_sleep(1); \
    if ((++_sp & 255u) == 0u) { if (xb_ld(&(bar)[XB_TMO])) break; if (_sp > XB_SPIN_CAP) { atomicAdd(&(bar)[XB_TMO], 1u); break; } } } } while (0)

struct XcdBarrier {
    unsigned* bar; unsigned x;
    volatile LAS unsigned* st;
};

__device__ __forceinline__ XcdBarrier xcd_barrier_post(unsigned* bar, volatile LAS unsigned* st) {
    XcdBarrier b; b.bar = bar; b.x = xb_xcc_id(); b.st = st;
    if (threadIdx.x == 0) (void)xb_add(&bar[XB_XCNT(b.x)], 1u);
    return b;
}
__device__ __forceinline__ void xcd_barrier_complete(unsigned* bar, unsigned x, unsigned& nloc, unsigned& nx) {
    const unsigned G = gridDim.x * gridDim.y * gridDim.z;
    unsigned sum, cnt, mine, sp = 0u;
    for (;;) {
        sum = 0u; cnt = 0u; mine = 0u;
#pragma unroll
        for (unsigned j = 0; j < 16; ++j) { const unsigned c = xb_ld(&bar[XB_XCNT(j)]); sum += c; cnt += (c > 0u) ? 1u : 0u; mine = (j == x) ? c : mine; }
        if (sum == G) break;
        __builtin_amdgcn_s_sleep(1);
        if ((++sp & 255u) == 0u) { if (xb_ld(&bar[XB_TMO])) break; if (sp > XB_SPIN_CAP) { atomicAdd(&bar[XB_TMO], 1u); break; } }
    }
    nloc = mine > 0u ? mine : 1u; nx = cnt > 0u ? cnt : 1u;
}

__device__ __forceinline__ void xcd_barrier(const XcdBarrier& b) {
    asm volatile("s_waitcnt vmcnt(0)" ::: "memory");
    __syncthreads();
    if (threadIdx.x == 0) {
        unsigned* bar = b.bar;
        __builtin_amdgcn_s_waitcnt(0);
        unsigned nloc = b.st[0], nx = b.st[1];
        if (nloc == 0u) { xcd_barrier_complete(bar, b.x, nloc, nx); b.st[0] = nloc; b.st[1] = nx; }
        const unsigned old = xb_add(&bar[XB_XSUB(b.x)], 1u);
        const unsigned gen = old / nloc;
        if (old + 1u == (gen + 1u) * nloc) {
            __builtin_amdgcn_fence(__ATOMIC_RELEASE, "agent");
            asm volatile("s_waitcnt vmcnt(0)" ::: "memory");
            const unsigned og = xb_add(&bar[XB_TOP], 1u);
            const unsigned tg = og / nx;
            if (og + 1u == (tg + 1u) * nx) xb_add(&bar[XB_TOPGEN], 1u);
            else XB_SPIN(xb_ld(&bar[XB_TOPGEN]) == tg, bar);
            __builtin_amdgcn_fence(__ATOMIC_ACQUIRE, "agent");
            xb_add(&bar[XB_XGEN(b.x)], 1u);
            asm volatile("s_waitcnt vmcnt(0)" ::: "memory");
        } else {
            XB_SPIN(xb_ld(&bar[XB_XGEN(b.x)]) == gen, bar);
            __builtin_amdgcn_fence(__ATOMIC_ACQUIRE, "agent");
            asm volatile("s_waitcnt vmcnt(0)" ::: "memory");
        }
    }
    __syncthreads();
}
#ifndef MK_N_LAUNCHES
#define MK_N_LAUNCHES 1
#endif
constexpr int DM = 1024, NPR = 16384, NSR = 1024, MR = NPR + NSR, SEQ = 8192, NPJ = 2560, FF = 4096, WIN_LD = 2320;
constexpr int C_Q = 0, C_K = 512, C_V = 640, C_GQ = 768, C_GK = 1024, C_GV = 1280, C_GR = 1792, C_Z = 2304;
constexpr float EPSN = 1e-6f, LOG2E = 1.4426950408889634f;
constexpr size_t O_YP = 0, O_YS = 16777216, O_KWP = 17825792, O_VWP = O_KWP + 32768, O_GLP = O_VWP + 32768, O_KWS = O_GLP + 65536, O_VWS = O_KWS + 2097152, O_GLS = O_VWS + 2097152;
constexpr size_t MiB = 1u << 20;
constexpr size_t WS_CTL = 0, CTL_ZERO_BYTES = 64 * 1024;
constexpr size_t WS_WDN = 1 * MiB, WS_WIN = 9 * MiB, WS_WOUT = 14 * MiB, WS_WUP = 16 * MiB;
constexpr size_t WS_XN = 24 * MiB, WS_PROJ = 58 * MiB, WS_MIX = 143 * MiB, WS_ST = 177 * MiB, WS_ABLK = 209 * MiB, WS_ROPE = 210 * MiB, WS_SS = 213 * MiB;
constexpr size_t WS_MIXOUT = 58 * MiB, WS_U = 58 * MiB, WS_F = 24 * MiB, WS_END = 216 * MiB;
constexpr int CW_BAR = 1024;
constexpr int RING_BYTES = 131072, MISC_OFF = RING_BYTES, LDS_BYTES = RING_BYTES + 1024;
constexpr int NPH = 10;

typedef short s16x4 __attribute__((ext_vector_type(4)));
typedef unsigned u32x2 __attribute__((ext_vector_type(2)));
typedef float f32x2v __attribute__((ext_vector_type(2)));
typedef __bf16 bf16x2_t __attribute__((ext_vector_type(2)));
__device__ __forceinline__ unsigned pkbf(float lo, float hi) { f32x2v v = {lo, hi}; bf16x2_t b = __builtin_convertvector(v, bf16x2_t); return __builtin_bit_cast(unsigned, b); }
__device__ __forceinline__ float bflo(unsigned w) { return __uint_as_float(w << 16); }
__device__ __forceinline__ float bfhi(unsigned w) { return __uint_as_float(w & 0xffff0000u); }
__device__ __forceinline__ float bf2f(bf16 b) { return __uint_as_float((unsigned)b << 16); }
__device__ __forceinline__ float wave_sum(float v) {
#pragma unroll
    for (int o = 1; o < 64; o <<= 1) v += __shfl_xor(v, o);
    return v;
}
__device__ __forceinline__ f32x4 mfma16(bf16x8 a, bf16x8 b, f32x4 c) { return __builtin_amdgcn_mfma_f32_16x16x32_bf16(a, b, c, 0, 0, 0); }
__device__ __forceinline__ float logsig16(float z) { return (fminf(z, 0.f) - __logf(1.f + __expf(-fabsf(z)))) * 0.0625f; }

struct Args { const float* in[17]; float* out; unsigned char* ws; double inv_freq[32]; int ph_lo, ph_hi, never, use_bar; };
enum { I_XP = 0, I_XS, I_CK, I_CV, I_SG, I_WIN, I_WGK2, I_BGK, I_GGLA, I_SINK, I_WOUT, I_GMPRE, I_GMPOST, I_GFPRE, I_GFPOST, I_WUP, I_WDN };

__device__ __forceinline__ void p0_transpose_item(const float* W, int ldw, int nblk, int K, bf16* WT, LAS float* scr, int item, int lane) {
    const int kb = item / nblk, nb = item % nblk, k0 = 64 * kb, n0 = 32 * nb;
#pragma unroll 8
    for (int i = 0; i < 32; ++i) { const int kk = 2 * i + (lane >> 5); scr[kk * 33 + (lane & 31)] = W[(size_t)(k0 + kk) * ldw + n0 + (lane & 31)]; }
    LDS_WAIT(); asm volatile("" ::: "memory");
    const int c = lane & 7;
#pragma unroll
    for (int j = 0; j < 4; ++j) { const int n = (lane >> 3) + 8 * j; const LAS float* s = scr + (8 * c) * 33 + n;
        v4u o; o.x = pkbf(s[0 * 33], s[1 * 33]); o.y = pkbf(s[2 * 33], s[3 * 33]); o.z = pkbf(s[4 * 33], s[5 * 33]); o.w = pkbf(s[6 * 33], s[7 * 33]);
        *(v4u*)(WT + (size_t)(n0 + n) * K + k0 + 8 * c) = o; }
    LDS_WAIT(); asm volatile("" ::: "memory");
}
__device__ __forceinline__ const float* xrow_ptr(const Args& a, int m) { return m < NPR ? a.in[I_XP] + (size_t)m * DM : a.in[I_XS] + (size_t)(m - NPR) * DM; }

__device__ __forceinline__ void phase0(const Args& a, LAS unsigned char* L, int G, int bid, int tid, int lane, int wave) {
    unsigned char* ws = a.ws;
    bf16* Win_t = (bf16*)(ws + WS_WIN); bf16* Wout_t = (bf16*)(ws + WS_WOUT); bf16* Wup_t = (bf16*)(ws + WS_WUP); bf16* Wdn_t = (bf16*)(ws + WS_WDN);
    const int gw = bid * 8 + wave, NGW = G * 8;
    LAS float* scr = (LAS float*)(L + wave * 16384);
    constexpr int I_IN = 16 * 72, I_OUT = 16 * 32, I_UP = 16 * 128, I_DN = 64 * 32, NITEMS = I_IN + I_OUT + I_UP + I_DN;
    for (int it = gw; it < NITEMS; it += NGW) {
        int r = it;
        if (r < I_IN) { p0_transpose_item(a.in[I_WIN], WIN_LD, 72, DM, Win_t, scr, r, lane); continue; } r -= I_IN;
        if (r < I_OUT) { p0_transpose_item(a.in[I_WOUT], DM, 32, DM, Wout_t, scr, r, lane); continue; } r -= I_OUT;
        if (r < I_UP) { p0_transpose_item(a.in[I_WUP], FF, 128, DM, Wup_t, scr, r, lane); continue; } r -= I_UP;
        p0_transpose_item(a.in[I_WDN], DM, 32, FF, Wdn_t, scr, r, lane);
    }
    const int gt = bid * 512 + tid, NGT = G * 512;
    for (int e = gt; e < 256 * 1024; e += NGT) { const int j = e >> 10, k = e & 1023; const float* wr = a.in[I_WIN] + (size_t)k * WIN_LD + 2304; const float* g2 = a.in[I_WGK2] + j;
        float s = 0.f;
#pragma unroll
        for (int r = 0; r < 16; ++r) s += wr[r] * g2[r * 256];
        Win_t[(size_t)(2304 + j) * DM + k] = (bf16)(pkbf(s, 0.f) & 0xffffu); }
    f32x2v* rope = (f32x2v*)(ws + WS_ROPE);
    for (int e = gt; e < 8200 * 32; e += NGT) { const int pidx = e >> 5, i = e & 31; const int pos = pidx < 8192 ? pidx : 16384 + pidx - 8192;
        const double ang = (double)pos * a.inv_freq[i]; const double q = rint(ang * 0.15915494309189535);
        double r = fma(-q, 6.283185307179586, ang); r = fma(-q, 2.4492935982947064e-16, r);
        const float rf = (float)r; rope[e] = (f32x2v){__cosf(rf), __sinf(rf)}; }
    bf16* XN = (bf16*)(ws + WS_XN); const float* g = a.in[I_GMPRE];
    for (int m = gw; m < MR; m += NGW) { const f32x4* xr = (const f32x4*)xrow_ptr(a, m) + lane; f32x4 v[4]; float s = 0.f;
#pragma unroll
        for (int j = 0; j < 4; ++j) { v[j] = xr[64 * j]; s += (v[j].x * v[j].x + v[j].y * v[j].y) + (v[j].z * v[j].z + v[j].w * v[j].w); }
        const float rstd = rsqrtf(wave_sum(s) * (1.f / DM) + EPSN);
        u32x2* o8 = (u32x2*)(XN + (size_t)m * DM) + lane;
#pragma unroll
        for (int j = 0; j < 4; ++j) { const f32x4 gg = ((const f32x4*)g)[lane + 64 * j]; o8[64 * j] = (u32x2){pkbf(v[j].x * rstd * gg.x, v[j].y * rstd * gg.y), pkbf(v[j].z * rstd * gg.z, v[j].w * rstd * gg.w)}; }
    }
}
constexpr int KROW = 144, VROW = 528, LDS_VT = 256 * KROW;
__device__ __forceinline__ void rope_half_row(const bf16* src, const f32x2v* tb, LAS unsigned char* dst, float* outf) {
    const v4u a0 = *(const v4u*)src, a1 = *(const v4u*)(src + 8), b0 = *(const v4u*)(src + 32), b1 = *(const v4u*)(src + 40);
    const unsigned w1[8] = {a0.x, a0.y, a0.z, a0.w, a1.x, a1.y, a1.z, a1.w}, w2[8] = {b0.x, b0.y, b0.z, b0.w, b1.x, b1.y, b1.z, b1.w};
    unsigned r1[8], r2[8];
#pragma unroll
    for (int i = 0; i < 8; ++i) { const f32x2v c0 = tb[2 * i], c1 = tb[2 * i + 1];
        const float x1a = bflo(w1[i]), x1b = bfhi(w1[i]), x2a = bflo(w2[i]), x2b = bfhi(w2[i]);
        const float y1a = x1a * c0.x - x2a * c0.y, y2a = x2a * c0.x + x1a * c0.y, y1b = x1b * c1.x - x2b * c1.y, y2b = x2b * c1.x + x1b * c1.y;
        r1[i] = pkbf(y1a, y1b); r2[i] = pkbf(y2a, y2b);
        if (outf) { outf[2 * i] = y1a; outf[2 * i + 1] = y1b; outf[32 + 2 * i] = y2a; outf[32 + 2 * i + 1] = y2b; } }
    *(LAS v4u*)dst = (v4u){r1[0], r1[1], r1[2], r1[3]}; *(LAS v4u*)(dst + 16) = (v4u){r1[4], r1[5], r1[6], r1[7]};
    *(LAS v4u*)(dst + 64) = (v4u){r2[0], r2[1], r2[2], r2[3]}; *(LAS v4u*)(dst + 80) = (v4u){r2[4], r2[5], r2[6], r2[7]};
}
__device__ __forceinline__ void vt_half_row(const bf16* src, LAS unsigned char* vt_col  , float* outf) {
#pragma unroll
    for (int c = 0; c < 4; ++c) { const v4u w = *(const v4u*)(src + 8 * c); const unsigned ww[4] = {w.x, w.y, w.z, w.w};
#pragma unroll
        for (int i = 0; i < 4; ++i) { const int d = 8 * c + 2 * i;
            *(LAS unsigned short*)(vt_col + d * VROW) = (unsigned short)(ww[i] & 0xffffu); *(LAS unsigned short*)(vt_col + (d + 1) * VROW) = (unsigned short)(ww[i] >> 16);
            if (outf) { outf[d] = bflo(ww[i]); outf[d + 1] = bfhi(ww[i]); } } }
}
__device__ __forceinline__ void load_q_frags(const bf16* src, const f32x2v* tb, bf16x8& q0, bf16x8& q1) {
    const v4u a = *(const v4u*)src, b = *(const v4u*)(src + 32); const unsigned w1[4] = {a.x, a.y, a.z, a.w}, w2[4] = {b.x, b.y, b.z, b.w}; unsigned r1[4], r2[4];
#pragma unroll
    for (int i = 0; i < 4; ++i) { const f32x2v c0 = tb[2 * i], c1 = tb[2 * i + 1];
        const float x1a = bflo(w1[i]), x1b = bfhi(w1[i]), x2a = bflo(w2[i]), x2b = bfhi(w2[i]);
        r1[i] = pkbf(x1a * c0.x - x2a * c0.y, x1b * c1.x - x2b * c1.y); r2[i] = pkbf(x2a * c0.x + x1a * c0.y, x2b * c1.x + x1b * c1.y); }
    q0 = __builtin_bit_cast(bf16x8, (v4u){r1[0], r1[1], r1[2], r1[3]}); q1 = __builtin_bit_cast(bf16x8, (v4u){r2[0], r2[1], r2[2], r2[3]});
}
template <bool SAMPLE> __device__ __forceinline__ void attn_qtile(LAS unsigned char* Ks, LAS unsigned char* Vt, bf16x8 q0, bf16x8 q1, int kt0, float sink2, int l15, int fq, bool first, int qt, bf16* outp) {
    f32x4 s[9];
#pragma unroll
    for (int r = 0; r < 9; ++r) { LAS unsigned char* kp = Ks + ((kt0 + r) * 16 + l15) * KROW + fq * 16;
        const bf16x8 k0 = *(LAS bf16x8*)kp, k1 = *(LAS bf16x8*)(kp + 64);
        f32x4 a = {0.f, 0.f, 0.f, 0.f}; a = mfma16(k0, q0, a); a = mfma16(k1, q1, a); s[r] = a; }
    const float C2 = 0.125f * LOG2E; float mx = -INFINITY;
#pragma unroll
    for (int r = 0; r < 9; ++r)
#pragma unroll
        for (int j = 0; j < 4; ++j) { bool ok;
            if (SAMPLE) { const int kidx = r * 16 + fq * 4 + j, t = l15 & 7; ok = (kidx > t) && (kidx <= t + 128); }
            else { ok = true; if (r == 0) ok = l15 < fq * 4 + j; if (r == 8) ok = l15 >= fq * 4 + j; if (first && (qt + r < 8)) ok = false; }
            const float v = ok ? s[r][j] * C2 : -INFINITY; s[r][j] = v; mx = fmaxf(mx, v); }
    mx = fmaxf(mx, __shfl_xor(mx, 16)); mx = fmaxf(mx, __shfl_xor(mx, 32));
    const float m = fmaxf(mx, sink2); float sum = 0.f;
#pragma unroll
    for (int r = 0; r < 9; ++r)
#pragma unroll
        for (int j = 0; j < 4; ++j) { const float p = __builtin_amdgcn_exp2f(s[r][j] - m); s[r][j] = p; sum += p; }
    sum += __shfl_xor(sum, 16); sum += __shfl_xor(sum, 32);
    const float inv = 1.f / (sum + __builtin_amdgcn_exp2f(sink2 - m));
    f32x4 o[4];
#pragma unroll
    for (int dt = 0; dt < 4; ++dt) o[dt] = (f32x4){0.f, 0.f, 0.f, 0.f};
#pragma unroll
    for (int c = 0; c < 5; ++c) {
        v4u pw; pw.x = pkbf(s[2 * c][0], s[2 * c][1]); pw.y = pkbf(s[2 * c][2], s[2 * c][3]);
        if (c < 4) { pw.z = pkbf(s[2 * c + 1][0], s[2 * c + 1][1]); pw.w = pkbf(s[2 * c + 1][2], s[2 * c + 1][3]); } else { pw.z = 0u; pw.w = 0u; }
        const bf16x8 pf = __builtin_bit_cast(bf16x8, pw);
#pragma unroll
        for (int dt = 0; dt < 4; ++dt) { LAS unsigned char* vp = Vt + (dt * 16 + l15) * VROW + ((kt0 + 2 * c) * 16 + fq * 4) * 2;
            const u32x2 lo = *(LAS u32x2*)vp; u32x2 hi = {0u, 0u}; if (c < 4) hi = *(LAS u32x2*)(vp + 32);
            const bf16x8 vf = __builtin_bit_cast(bf16x8, (v4u){lo.x, lo.y, hi.x, hi.y});
            o[dt] = mfma16(vf, pf, o[dt]); } }
#pragma unroll
    for (int dt = 0; dt < 4; ++dt) *(u32x2*)(outp + dt * 16 + fq * 4) = (u32x2){pkbf(o[dt][0] * inv, o[dt][1] * inv), pkbf(o[dt][2] * inv, o[dt][3] * inv)};
}

__device__ __forceinline__ void attn_prompt_unit(const Args& a, LAS unsigned char* L, int u, int tid, int lane, int wave) {
    const bf16* PROJ = (const bf16*)(a.ws + WS_PROJ); bf16* MIX = (bf16*)(a.ws + WS_MIX); const f32x2v* ROPE = (const f32x2v*)(a.ws + WS_ROPE);
    const int b = u >> 7, n = (u >> 1) & 63, kvh = u & 1;
    LAS unsigned char* Ks = L; LAS unsigned char* Vt = L + LDS_VT;
    __syncthreads();
    { const int key = tid >> 1, hf = tid & 1, kpos = (n - 1) * 128 + key;
      if (kpos >= 0) { const bf16* rowp = PROJ + (size_t)(b * SEQ + kpos) * NPJ; const bool wout = (n == 63) && (key >= 128); const size_t oidx = ((size_t)(b * 128 + key - 128) * 2 + kvh) * 64;
          rope_half_row(rowp + C_K + kvh * 64 + hf * 16, ROPE + (size_t)kpos * 32 + hf * 16, Ks + key * KROW + hf * 32, wout ? a.out + O_KWP + oidx + hf * 16 : nullptr);
          vt_half_row(rowp + C_V + kvh * 64 + hf * 32, Vt + (hf * 32) * VROW + key * 2, wout ? a.out + O_VWP + oidx + hf * 32 : nullptr); }
      else { const v4u z = {0u, 0u, 0u, 0u}; LAS unsigned char* kd = Ks + key * KROW + hf * 32; *(LAS v4u*)kd = z; *(LAS v4u*)(kd + 16) = z; *(LAS v4u*)(kd + 64) = z; *(LAS v4u*)(kd + 80) = z;
#pragma unroll
          for (int d = 0; d < 32; ++d) *(LAS unsigned short*)(Vt + (hf * 32 + d) * VROW + key * 2) = 0; } }
    __syncthreads();
    const int l15 = lane & 15, fq = lane >> 4, g = wave >> 1; const float sink2 = a.in[I_SINK][kvh * 4 + g] * LOG2E;
    for (int i = 0; i < 4; ++i) { const int qt = (wave & 1) * 4 + i, qpos = n * 128 + qt * 16 + l15; const size_t row = (size_t)b * SEQ + qpos;
        bf16x8 q0, q1; load_q_frags(PROJ + row * NPJ + C_Q + (kvh * 4 + g) * 64 + fq * 8, ROPE + (size_t)qpos * 32 + fq * 8, q0, q1);
        attn_qtile<false>(Ks, Vt, q0, q1, qt, sink2, l15, fq, n == 0, qt, MIX + row * DM + (kvh * 4 + g) * 64); }
}

__device__ __forceinline__ void attn_sample_unit(const Args& a, LAS unsigned char* L, int u, int tid, int lane, int wave) {
    const bf16* PROJ = (const bf16*)(a.ws + WS_PROJ); bf16* MIX = (bf16*)(a.ws + WS_MIX); const f32x2v* ROPE = (const f32x2v*)(a.ws + WS_ROPE);
    const int b = u >> 1, kvh = u & 1;
    LAS unsigned char* Ks = L; LAS unsigned char* Vt = L + LDS_VT;
    __syncthreads();
    { const int key = tid >> 2, qd = tid & 3; const size_t ci = ((size_t)(b * 128 + key) * 2 + kvh) * 64 + qd * 16; const f32x4* ck = (const f32x4*)(a.in[I_CK] + ci); const f32x4* cv = (const f32x4*)(a.in[I_CV] + ci);
      f32x4 kv[4], vv[4];
#pragma unroll
      for (int c = 0; c < 4; ++c) { kv[c] = ck[c]; vv[c] = cv[c]; }
      LAS unsigned char* kd = Ks + key * KROW + qd * 32;
      *(LAS v4u*)kd = (v4u){pkbf(kv[0].x, kv[0].y), pkbf(kv[0].z, kv[0].w), pkbf(kv[1].x, kv[1].y), pkbf(kv[1].z, kv[1].w)};
      *(LAS v4u*)(kd + 16) = (v4u){pkbf(kv[2].x, kv[2].y), pkbf(kv[2].z, kv[2].w), pkbf(kv[3].x, kv[3].y), pkbf(kv[3].z, kv[3].w)};
#pragma unroll
      for (int c = 0; c < 4; ++c) { const unsigned p0 = pkbf(vv[c].x, vv[c].y), p1 = pkbf(vv[c].z, vv[c].w); LAS unsigned char* vp = Vt + (qd * 16 + c * 4) * VROW + key * 2;
          *(LAS unsigned short*)vp = (unsigned short)(p0 & 0xffffu); *(LAS unsigned short*)(vp + VROW) = (unsigned short)(p0 >> 16);
          *(LAS unsigned short*)(vp + 2 * VROW) = (unsigned short)(p1 & 0xffffu); *(LAS unsigned short*)(vp + 3 * VROW) = (unsigned short)(p1 >> 16); }
      if (key >= 8) { const size_t oi = ((size_t)(b * 128 + key - 8) * 2 + kvh) * 64 + qd * 16; f32x4* ok = (f32x4*)(a.out + O_KWS + oi); f32x4* ov = (f32x4*)(a.out + O_VWS + oi);
#pragma unroll
          for (int c = 0; c < 4; ++c) { ok[c] = kv[c]; ov[c] = vv[c]; } } }
    if (tid < 16) { const int kk = tid >> 1, hf = tid & 1; const bf16* rowp = PROJ + (size_t)(NPR + b * 8 + kk) * NPJ; const size_t oidx = ((size_t)(b * 128 + 120 + kk) * 2 + kvh) * 64;
        rope_half_row(rowp + C_K + kvh * 64 + hf * 16, ROPE + (size_t)(8192 + kk) * 32 + hf * 16, Ks + (128 + kk) * KROW + hf * 32, a.out + O_KWS + oidx + hf * 16); }
    else if (tid < 32) { const int kk = (tid - 16) >> 1, hf = tid & 1; const bf16* rowp = PROJ + (size_t)(NPR + b * 8 + kk) * NPJ; const size_t oidx = ((size_t)(b * 128 + 120 + kk) * 2 + kvh) * 64;
        vt_half_row(rowp + C_V + kvh * 64 + hf * 32, Vt + (hf * 32) * VROW + (128 + kk) * 2, a.out + O_VWS + oidx + hf * 32); }
    else if (tid >= 64 && tid < 64 + 72) { *(LAS v4u*)(Ks + 136 * KROW + (tid - 64) * 16) = (v4u){0u, 0u, 0u, 0u}; }
    else if (tid >= 192 && tid < 256) { *(LAS v4u*)(Vt + (tid - 192) * VROW + 272) = (v4u){0u, 0u, 0u, 0u}; }
    __syncthreads();
    if (wave < 2) { const int l15 = lane & 15, fq = lane >> 4, g = wave * 2 + (l15 >> 3), t = l15 & 7; const size_t row = (size_t)NPR + b * 8 + t;
        const float sink2 = a.in[I_SINK][kvh * 4 + g] * LOG2E;
        bf16x8 q0, q1; load_q_frags(PROJ + row * NPJ + C_Q + (kvh * 4 + g) * 64 + fq * 8, ROPE + (size_t)(8192 + t) * 32 + fq * 8, q0, q1);
        attn_qtile<true>(Ks, Vt, q0, q1, 0, sink2, l15, fq, false, 0, MIX + row * DM + (kvh * 4 + g) * 64); }
}
constexpr int GROW = 144;
__device__ __forceinline__ void gla_cumsum(const bf16* prow0, int h, const float* b_gk, LAS float* red, int tid, float (&bc)[8], float& blast) {
    const int k = tid & 63, tg = tid >> 6; const float bias = b_gk[h * 64 + k]; float run = 0.f;
#pragma unroll
    for (int i = 0; i < 8; ++i) { const float z = bf2f(prow0[(size_t)(tg * 8 + i) * NPJ + C_Z + h * 64 + k]) + bias; run += logsig16(z); bc[i] = run; }
    red[tg * 64 + k] = run; __syncthreads();
    float pre = 0.f, tot = 0.f;
#pragma unroll
    for (int g = 0; g < 8; ++g) { const float r = red[g * 64 + k]; tot += r; if (g < tg) pre += r; }
#pragma unroll
    for (int i = 0; i < 8; ++i) bc[i] += pre;
    blast = tot;
}
__device__ __forceinline__ void gla_load_vt(const bf16* prow0, int h, LAS unsigned char* VT, int tid) {
    const int v = tid & 127, tq = tid >> 7;
#pragma unroll
    for (int i = 0; i < 8; ++i) { const int t = tq * 16 + 2 * i; const unsigned lo = prow0[(size_t)t * NPJ + C_GV + h * 128 + v], hi = prow0[(size_t)(t + 1) * NPJ + C_GV + h * 128 + v];
        *(LAS unsigned*)(VT + v * GROW + t * 2) = lo | (hi << 16); }
}
__device__ __forceinline__ void gla_local_unit(const Args& a, LAS unsigned char* L, int uid, int tid, int lane, int wave) {
    const int bh = uid >> 7, c = uid & 127, b = bh >> 2, h = bh & 3;
    const bf16* prow0 = (const bf16*)(a.ws + WS_PROJ) + (size_t)(b * SEQ + c * 64) * NPJ;
    LAS unsigned char* KdT = L; LAS unsigned char* VT = L + 64 * GROW; LAS float* red = (LAS float*)(L + 64 * GROW + 128 * GROW);
    __syncthreads();
    float bc[8], blast; gla_cumsum(prow0, h, a.in[I_BGK], red, tid, bc, blast);
    { const int k = tid & 63, tg = tid >> 6; unsigned w[4];
#pragma unroll
      for (int i = 0; i < 4; ++i) { const float k0 = bf2f(prow0[(size_t)(tg * 8 + 2 * i) * NPJ + C_GK + h * 64 + k]) * __expf(blast - bc[2 * i]);
          const float k1 = bf2f(prow0[(size_t)(tg * 8 + 2 * i + 1) * NPJ + C_GK + h * 64 + k]) * __expf(blast - bc[2 * i + 1]); w[i] = pkbf(k0, k1); }
      *(LAS v4u*)(KdT + k * GROW + tg * 16) = (v4u){w[0], w[1], w[2], w[3]};
      if (tg == 0) ((float*)(a.ws + WS_ABLK))[(size_t)uid * 64 + k] = __expf(blast); }
    gla_load_vt(prow0, h, VT, tid);
    __syncthreads();
    const int l15 = lane & 15, fq = lane >> 4, vt = wave;
    bf16x8 vf[2];
#pragma unroll
    for (int ks = 0; ks < 2; ++ks) vf[ks] = *(LAS bf16x8*)(VT + (vt * 16 + l15) * GROW + ks * 64 + fq * 16);
    float* ST = (float*)(a.ws + WS_ST) + (size_t)uid * 8192;
#pragma unroll
    for (int kt = 0; kt < 4; ++kt) { f32x4 acc = {0.f, 0.f, 0.f, 0.f};
#pragma unroll
        for (int ks = 0; ks < 2; ++ks) { const bf16x8 kf = *(LAS bf16x8*)(KdT + (kt * 16 + l15) * GROW + ks * 64 + fq * 16); acc = mfma16(vf[ks], kf, acc); }
#pragma unroll
        for (int j = 0; j < 4; ++j) ST[(vt * 16 + fq * 4 + j) * 64 + kt * 16 + l15] = acc[j]; }
}
__device__ __forceinline__ void gla_scan(const Args& a, int id) {
    const int bh = id >> 13, e = id & 8191, k = e & 63, v = e >> 6;
    float* ST = (float*)(a.ws + WS_ST) + (size_t)bh * 128 * 8192 + e; const float* AB = (const float*)(a.ws + WS_ABLK) + (size_t)bh * 128 * 64 + k;
    float carry = 0.f;
    for (int c0 = 0; c0 < 128; c0 += 8) { float u[8], ab[8];
#pragma unroll
        for (int i = 0; i < 8; ++i) { u[i] = ST[(size_t)(c0 + i) * 8192]; ab[i] = AB[(c0 + i) * 64]; }
#pragma unroll
        for (int i = 0; i < 8; ++i) { ST[(size_t)(c0 + i) * 8192] = carry; carry = ab[i] * carry + u[i]; } }
    a.out[O_GLP + (size_t)bh * 8192 + k * 128 + v] = carry;
}
__device__ __forceinline__ void gla_out_unit(const Args& a, LAS unsigned char* L, int uid, int tid, int lane, int wave) {
    const int bh = uid >> 7, c = uid & 127, b = bh >> 2, h = bh & 3; const size_t row0 = (size_t)b * SEQ + c * 64;
    const bf16* prow0 = (const bf16*)(a.ws + WS_PROJ) + row0 * NPJ;
    LAS unsigned char* Qt = L; LAS unsigned char* Kt = L + 64 * GROW; LAS unsigned char* VT = L + 128 * GROW; LAS float* red = (LAS float*)(L + 256 * GROW); LAS float* nrm = red + 512;
    __syncthreads();
    float bc[8], blast; gla_cumsum(prow0, h, a.in[I_BGK], red, tid, bc, blast);
    { const int k = tid & 63, tg = tid >> 6;
#pragma unroll
      for (int i = 0; i < 8; ++i) { const int t = tg * 8 + i; const float q = bf2f(prow0[(size_t)t * NPJ + C_GQ + h * 64 + k]) * 0.125f * __expf(bc[i]), kk = bf2f(prow0[(size_t)t * NPJ + C_GK + h * 64 + k]) * __expf(-bc[i]);
          *(LAS unsigned short*)(Qt + t * GROW + k * 2) = (unsigned short)(pkbf(q, 0.f) & 0xffffu); *(LAS unsigned short*)(Kt + t * GROW + k * 2) = (unsigned short)(pkbf(kk, 0.f) & 0xffffu); } }
    gla_load_vt(prow0, h, VT, tid);
    __syncthreads();
    const int l15 = lane & 15, fq = lane >> 4, tt = wave & 3, vh = wave >> 2;
    bf16x8 qf[2];
#pragma unroll
    for (int ks = 0; ks < 2; ++ks) qf[ks] = *(LAS bf16x8*)(Qt + (tt * 16 + l15) * GROW + ks * 64 + fq * 16);
    f32x4 at[4];
#pragma unroll
    for (int st = 0; st < 4; ++st) { f32x4 acc = {0.f, 0.f, 0.f, 0.f};
        if (st <= tt) {
#pragma unroll
            for (int ks = 0; ks < 2; ++ks) { const bf16x8 kf = *(LAS bf16x8*)(Kt + (st * 16 + l15) * GROW + ks * 64 + fq * 16); acc = mfma16(kf, qf[ks], acc); }
            if (st == tt) {
#pragma unroll
                for (int j = 0; j < 4; ++j) if (fq * 4 + j > l15) acc[j] = 0.f; } }
        at[st] = acc; }
    bf16x8 pf[2];
#pragma unroll
    for (int cc = 0; cc < 2; ++cc) pf[cc] = __builtin_bit_cast(bf16x8, (v4u){pkbf(at[2 * cc][0], at[2 * cc][1]), pkbf(at[2 * cc][2], at[2 * cc][3]), pkbf(at[2 * cc + 1][0], at[2 * cc + 1][1]), pkbf(at[2 * cc + 1][2], at[2 * cc + 1][3])});
    const float* ST = (const float*)(a.ws + WS_ST) + (size_t)uid * 8192;
    f32x4 acc[4]; float ssq = 0.f;
#pragma unroll
    for (int vi = 0; vi < 4; ++vi) { const int vt = vh * 4 + vi; f32x4 o = {0.f, 0.f, 0.f, 0.f};
#pragma unroll
        for (int ks = 0; ks < 2; ++ks) { const f32x4* sp = (const f32x4*)(ST + (vt * 16 + l15) * 64 + ks * 32 + fq * 8); const f32x4 s0 = sp[0], s1 = sp[1];
            const bf16x8 sf = __builtin_bit_cast(bf16x8, (v4u){pkbf(s0.x, s0.y), pkbf(s0.z, s0.w), pkbf(s1.x, s1.y), pkbf(s1.z, s1.w)}); o = mfma16(sf, qf[ks], o); }
#pragma unroll
        for (int cc = 0; cc < 2; ++cc) if (2 * cc <= tt) { LAS unsigned char* vp = VT + (vt * 16 + l15) * GROW + (cc * 32 + fq * 4) * 2; const u32x2 lo = *(LAS u32x2*)vp, hi = *(LAS u32x2*)(vp + 32);
            o = mfma16(__builtin_bit_cast(bf16x8, (v4u){lo.x, lo.y, hi.x, hi.y}), pf[cc], o); }
        acc[vi] = o; ssq += (o[0] * o[0] + o[1] * o[1]) + (o[2] * o[2] + o[3] * o[3]); }
    ssq += __shfl_xor(ssq, 16); ssq += __shfl_xor(ssq, 32);
    if (fq == 0) nrm[vh * 64 + tt * 16 + l15] = ssq;
    __syncthreads();
    const int t = tt * 16 + l15; const float rstd = rsqrtf((nrm[t] + nrm[64 + t]) * (1.f / 128.f) + EPSN);
    bf16* MIX = (bf16*)(a.ws + WS_MIX) + (row0 + t) * DM + 512 + h * 128; const bf16* grp = prow0 + (size_t)t * NPJ + C_GR + h * 128; const float* gg = a.in[I_GGLA];
#pragma unroll
    for (int vi = 0; vi < 4; ++vi) { const int v0 = (vh * 4 + vi) * 16 + fq * 4; const u32x2 gw = *(const u32x2*)(grp + v0); const f32x4 g4 = *(const f32x4*)(gg + v0);
        const float r0 = bflo(gw.x), r1 = bfhi(gw.x), r2 = bflo(gw.y), r3 = bfhi(gw.y);
        const float o0 = acc[vi][0] * rstd * g4.x * (r0 / (1.f + __expf(-r0))), o1 = acc[vi][1] * rstd * g4.y * (r1 / (1.f + __expf(-r1)));
        const float o2 = acc[vi][2] * rstd * g4.z * (r2 / (1.f + __expf(-r2))), o3 = acc[vi][3] * rstd * g4.w * (r3 / (1.f + __expf(-r3)));
        *(u32x2*)(MIX + v0) = (u32x2){pkbf(o0, o1), pkbf(o2, o3)}; }
}
__device__ __forceinline__ void gla_sample_unit(const Args& a, LAS unsigned char* L, int u, int tid, int lane, int wave) {
    const int b = u >> 2, h = u & 3; const size_t row0 = (size_t)NPR + b * 8;
    const bf16* prow0 = (const bf16*)(a.ws + WS_PROJ) + row0 * NPJ;
    LAS float* BS = (LAS float*)L; LAS float* QD = BS + 512; LAS float* KD = QD + 512; LAS float* KE = KD + 512; LAS float* AB = KE + 512; LAS float* AT = AB + 64; LAS float* OP = AT + 64; LAS float* NR = OP + 4096;
    __syncthreads();
    { const int k = tid & 63, t = tid >> 6; BS[t * 64 + k] = logsig16(bf2f(prow0[(size_t)t * NPJ + C_Z + h * 64 + k]) + a.in[I_BGK][h * 64 + k]); }
    __syncthreads();
    { const int k = tid & 63, t = tid >> 6; float bt = 0.f, bl = 0.f;
#pragma unroll
      for (int i = 0; i < 8; ++i) { const float l = BS[i * 64 + k]; bl += l; if (i <= t) bt += l; }
      const float q = bf2f(prow0[(size_t)t * NPJ + C_GQ + h * 64 + k]) * 0.125f, kk = bf2f(prow0[(size_t)t * NPJ + C_GK + h * 64 + k]);
      QD[t * 64 + k] = q * __expf(bt); KD[t * 64 + k] = kk * __expf(bl - bt); KE[t * 64 + k] = kk * __expf(-bt); if (t == 0) AB[k] = __expf(bl); }
    __syncthreads();
    if (tid < 64) { const int t = tid >> 3, s = tid & 7; float acc = 0.f;
        if (s <= t) { for (int k = 0; k < 64; ++k) acc += QD[t * 64 + k] * KE[s * 64 + k]; }
        AT[t * 8 + s] = acc; }
    const int v = tid & 127, kq = tid >> 7;
    float vv[8], acc[8];
#pragma unroll
    for (int t = 0; t < 8; ++t) { vv[t] = bf2f(prow0[(size_t)t * NPJ + C_GV + h * 128 + v]); acc[t] = 0.f; }
    const float* S0 = a.in[I_SG] + (size_t)u * 8192; float* SN = a.out + O_GLS + (size_t)u * 8192;
#pragma unroll 4
    for (int kk = 0; kk < 16; ++kk) { const int k = kq * 16 + kk; const float s0 = S0[k * 128 + v]; float sn = AB[k] * s0;
#pragma unroll
        for (int t = 0; t < 8; ++t) { acc[t] += QD[t * 64 + k] * s0; sn += KD[t * 64 + k] * vv[t]; }
        SN[k * 128 + v] = sn; }
#pragma unroll
    for (int t = 0; t < 8; ++t) OP[(kq * 8 + t) * 128 + v] = acc[t];
    __syncthreads();
    float o[2];
#pragma unroll
    for (int ti = 0; ti < 2; ++ti) { const int t = kq * 2 + ti; float x = (OP[t * 128 + v] + OP[(8 + t) * 128 + v]) + (OP[(16 + t) * 128 + v] + OP[(24 + t) * 128 + v]);
#pragma unroll
        for (int s = 0; s < 8; ++s) x += AT[t * 8 + s] * vv[s];
        o[ti] = x; const float ss = wave_sum(x * x); if (lane == 0) NR[wave * 2 + ti] = ss; }
    __syncthreads();
    bf16* MIX = (bf16*)(a.ws + WS_MIX);
#pragma unroll
    for (int ti = 0; ti < 2; ++ti) { const int t = kq * 2 + ti; const float rstd = rsqrtf((NR[(kq * 2) * 2 + ti] + NR[(kq * 2 + 1) * 2 + ti]) * (1.f / 128.f) + EPSN);
        const float r = bf2f(prow0[(size_t)t * NPJ + C_GR + h * 128 + v]);
        MIX[(row0 + t) * DM + 512 + h * 128 + v] = (bf16)(pkbf(o[ti] * rstd * a.in[I_GGLA][v] * (r / (1.f + __expf(-r))), 0.f) & 0xffffu); }
}
__device__ __forceinline__ void phase6(const Args& a, int G, int bid, int lane, int wave) {
    const int gw = bid * 8 + wave, NGW = G * 8; const bf16* MO = (const bf16*)(a.ws + WS_MIXOUT); const float* SS = (const float*)(a.ws + WS_SS); bf16* XN = (bf16*)(a.ws + WS_XN);
    const f32x4* g1 = (const f32x4*)a.in[I_GMPOST]; const f32x4* g2 = (const f32x4*)a.in[I_GFPRE];
    for (int m = gw; m < MR; m += NGW) { const f32x4* xr = (const f32x4*)xrow_ptr(a, m) + lane; const u32x2* mo = (const u32x2*)(MO + (size_t)m * DM) + lane;
        const float rstd1 = rsqrtf(wave_sum(SS[(size_t)m * 16 + (lane & 15)]) * (0.25f / DM) + EPSN);
        f32x4 x1[4]; float s = 0.f;
#pragma unroll
        for (int j = 0; j < 4; ++j) { const f32x4 x = xr[64 * j], g = g1[lane + 64 * j]; const u32x2 w = mo[64 * j];
            x1[j].x = x.x + bflo(w.x) * rstd1 * g.x; x1[j].y = x.y + bfhi(w.x) * rstd1 * g.y; x1[j].z = x.z + bflo(w.y) * rstd1 * g.z; x1[j].w = x.w + bfhi(w.y) * rstd1 * g.w;
            s += (x1[j].x * x1[j].x + x1[j].y * x1[j].y) + (x1[j].z * x1[j].z + x1[j].w * x1[j].w); }
        const float rstd2 = rsqrtf(wave_sum(s) * (1.f / DM) + EPSN);
        f32x4* yo = (f32x4*)(a.out + (size_t)m * DM) + lane; u32x2* o8 = (u32x2*)(XN + (size_t)m * DM) + lane;
#pragma unroll
        for (int j = 0; j < 4; ++j) { const f32x4 g = g2[lane + 64 * j]; yo[64 * j] = x1[j];
            o8[64 * j] = (u32x2){pkbf(x1[j].x * rstd2 * g.x, x1[j].y * rstd2 * g.y), pkbf(x1[j].z * rstd2 * g.z, x1[j].w * rstd2 * g.w)}; } }
}
__device__ __forceinline__ void phase9(const Args& a, int G, int bid, int lane, int wave) {
    const int gw = bid * 8 + wave, NGW = G * 8; const bf16* F = (const bf16*)(a.ws + WS_F); const float* SS = (const float*)(a.ws + WS_SS); const f32x4* g1 = (const f32x4*)a.in[I_GFPOST];
    for (int m = gw; m < MR; m += NGW) { f32x4* yo = (f32x4*)(a.out + (size_t)m * DM) + lane; const u32x2* fo = (const u32x2*)(F + (size_t)m * DM) + lane;
        const float rstd = rsqrtf(wave_sum(SS[(size_t)m * 16 + (lane & 15)]) * (0.25f / DM) + EPSN);
#pragma unroll
        for (int j = 0; j < 4; ++j) { f32x4 x = yo[64 * j]; const f32x4 g = g1[lane + 64 * j]; const u32x2 w = fo[64 * j];
            x.x += bflo(w.x) * rstd * g.x; x.y += bfhi(w.x) * rstd * g.y; x.z += bflo(w.y) * rstd * g.z; x.w += bfhi(w.y) * rstd * g.w; yo[64 * j] = x; } }
}
__global__ void __launch_bounds__(512, 2) mk_fwd(Args args) {
    extern __shared__ __attribute__((aligned(16))) unsigned char lds[];
    LAS unsigned char* L = (LAS unsigned char*)lds;
    volatile LAS unsigned* MISC = (volatile LAS unsigned*)(L + MISC_OFF);
    const int tid = threadIdx.x, lane = tid & 63, wave = __builtin_amdgcn_readfirstlane(tid >> 6);
    const int G = gridDim.x, bid = blockIdx.x;
    if (tid < 64) MISC[tid] = 0u;
    __syncthreads();
    if (args.never) cooperative_groups::this_grid().sync();
    unsigned* barw = (unsigned*)(args.ws + WS_CTL) + CW_BAR;
    XcdBarrier bar; bar.bar = barw; bar.x = 0; bar.st = nullptr;
    if (args.use_bar) bar = xcd_barrier_post(barw, MISC + 8);
    const int lo = args.ph_lo, hi = args.ph_hi;
#define IN(k) (lo <= (k) && (k) < hi)
#define SEAM(k) do { if (IN(k) && IN((k) + 1)) xcd_barrier(bar); } while (0)
    unsigned char* ws = args.ws;
    if (IN(0)) { phase0(args, L, G, bid, tid, lane, wave); SEAM(0); }
    if (IN(1)) { pg8::Gemm g{(const bf16*)(ws + WS_XN), (const bf16*)(ws + WS_WIN), MR, NPJ, DM}; pg8::StaticOrder S; S.init(MR, NPJ, G, bid);
        pg8::EpiMk<0, false> E{(bf16*)(ws + WS_PROJ), NPJ, nullptr};
        pg8::gemm_phase<pg8::EpiMk<0, false>, pg8::StaticOrder, true, true>(L, g, S, E); SEAM(1); }
    if (IN(2)) {
        for (int u = bid; u < 256; u += G) attn_prompt_unit(args, L, u, tid, lane, wave);
        for (int u = bid; u < 256; u += G) attn_sample_unit(args, L, u, tid, lane, wave);
        for (int u = bid; u < 1024; u += G) gla_local_unit(args, L, u, tid, lane, wave);
        SEAM(2); }
    if (IN(3)) { const int gs = G >> 1;
        if (bid < gs) { for (int id = bid * 512 + tid; id < 65536; id += gs * 512) gla_scan(args, id); }
        else { for (int u = bid - gs; u < 512; u += G - gs) gla_sample_unit(args, L, u, tid, lane, wave); }
        SEAM(3); }
    if (IN(4)) { for (int u = bid; u < 1024; u += G) gla_out_unit(args, L, u, tid, lane, wave); SEAM(4); }
    if (IN(5)) { pg8::Gemm g{(const bf16*)(ws + WS_MIX), (const bf16*)(ws + WS_WOUT), MR, DM, DM}; pg8::StaticOrder S; S.init(MR, DM, G, bid);
        pg8::EpiMk<0, true> E{(bf16*)(ws + WS_MIXOUT), DM, (float*)(ws + WS_SS)};
        pg8::gemm_phase<pg8::EpiMk<0, true>, pg8::StaticOrder, true, true>(L, g, S, E); SEAM(5); }
    if (IN(6)) { phase6(args, G, bid, lane, wave); SEAM(6); }
    if (IN(7)) { pg8::Gemm g{(const bf16*)(ws + WS_XN), (const bf16*)(ws + WS_WUP), MR, FF, DM}; pg8::StaticOrder S; S.init(MR, FF, G, bid);
        pg8::EpiMk<1, false> E{(bf16*)(ws + WS_U), FF, nullptr};
        pg8::gemm_phase<pg8::EpiMk<1, false>, pg8::StaticOrder, true, true>(L, g, S, E); SEAM(7); }
    if (IN(8)) { pg8::Gemm g{(const bf16*)(ws + WS_U), (const bf16*)(ws + WS_WDN), MR, DM, FF}; pg8::StaticOrder S; S.init(MR, DM, G, bid);
        pg8::EpiMk<0, true> E{(bf16*)(ws + WS_F), DM, (float*)(ws + WS_SS)};
        pg8::gemm_phase<pg8::EpiMk<0, true>, pg8::StaticOrder, true, true>(L, g, S, E); SEAM(8); }
    if (IN(9)) { phase9(args, G, bid, lane, wave); }
#undef IN
#undef SEAM
}

extern "C" void kernel_launch(void* const* d_in, const int* in_sizes, int n_in, void* d_out, int out_size, void* d_ws, size_t ws_size, hipStream_t stream) {
    static int grid = 0;
    if (grid == 0) {
        if (n_in != 17 || ws_size < WS_END) { fprintf(stderr, "kernel_launch: unexpected n_in %d / ws %zu\n", n_in, ws_size); grid = -1; return; }
        int dev = 0, cus = 0, per_cu = 0;
        if (hipGetDevice(&dev) != hipSuccess || hipDeviceGetAttribute(&cus, hipDeviceAttributeMultiprocessorCount, dev) != hipSuccess) { grid = -1; return; }
        if (hipFuncSetAttribute((const void*)mk_fwd, hipFuncAttributeMaxDynamicSharedMemorySize, LDS_BYTES) != hipSuccess) { fprintf(stderr, "kernel_launch: hipFuncSetAttribute failed\n"); grid = -1; return; }
        if (hipOccupancyMaxActiveBlocksPerMultiprocessor(&per_cu, (const void*)mk_fwd, 512, LDS_BYTES) != hipSuccess || per_cu < 1) { fprintf(stderr, "kernel_launch: occupancy query says %d\n", per_cu); per_cu = 1; }
        (void)hipGetLastError();
        grid = cus * 1;
        if (grid & 1) grid -= 1;
    }
    if (grid < 0) return;
    (void)hipMemsetAsync((char*)d_ws + WS_CTL, 0, CTL_ZERO_BYTES, stream);
    Args a{};
    for (int i = 0; i < 17; ++i) a.in[i] = (const float*)d_in[i];
    a.out = (float*)d_out; a.ws = (unsigned char*)d_ws;
    for (int i = 0; i < 32; ++i) a.inv_freq[i] = pow(10000.0, -(double)i / 32.0);
    a.never = 0;
#if MK_N_LAUNCHES == 1
    a.ph_lo = 0; a.ph_hi = NPH; a.use_bar = 1;
    void* kargs[] = {&a};
    hipError_t e = hipLaunchCooperativeKernel((const void*)mk_fwd, dim3(grid), dim3(512), kargs, LDS_BYTES, stream);
    if (e != hipSuccess) fprintf(stderr, "kernel_launch: cooperative launch failed: %s (grid %d)\n", hipGetErrorString(e), grid);
#else
    a.use_bar = 0;
    for (int p = 0; p < NPH; ++p) { a.ph_lo = p; a.ph_hi = p + 1; hipLaunchKernelGGL(mk_fwd, dim3(grid), dim3(512), LDS_BYTES, stream, a); }
#endif
}
```

```cpp
#include <hip/hip_cooperative_groups.h>
#include <cmath>
#include <hip/hip_runtime.h>
#include <cstdio>
#include <cstdint>
namespace pg8 {
#define PG8_LAS __attribute__((address_space(3)))
typedef unsigned short bf16_t;
typedef short bf16x8 __attribute__((ext_vector_type(8)));
typedef float f32x4 __attribute__((ext_vector_type(4)));
typedef unsigned u32x4 __attribute__((ext_vector_type(4)));
constexpr int BM = 256, BK = 64, HALF = 128, HTB = HALF * BK * 2  , STAGE_BYTES = 8 * HTB, NXCD = 8, WGM = 8;

__host__ __device__ __forceinline__ int lds_byte(int r, int c) { const int st = (r >> 4) * 2 + (c >> 5), rr = r & 15, cc = c & 31, ob = rr * 64 + cc * 2; return st * 1024 + (ob ^ (((ob >> 9) & 1) << 5)); }
__host__ __device__ __forceinline__ void stage_rc(int b, int& R, int& C) { const int st = b / 1024, sb = b % 1024, swz = sb ^ (((sb >> 9) & 1) << 5); R = (st >> 1) * 16 + swz / 64; C = (st & 1) * 32 + (swz % 64) / 2; }
__host__ __device__ __forceinline__ int perm32(int rho) { const int n = rho >> 4, i = rho & 15; return 8 * (i >> 2) + 4 * n + (i & 3); }

struct Unit { int pm, pn, k0, nt; float* pl; };
struct Gemm { const bf16_t* A; const bf16_t* Bt; int M, N, K; };

struct StaticOrder {
    int nM, nN, nwg, G, c, ntk;
    __host__ __device__ void init(int M, int N, int G_, int c_, int K_) { nM = M / BM; nN = N / BM; nwg = nM * nN; G = G_; c = c_; ntk = K_ / BK; }
    __host__ __device__ bool next(int i, Unit& u) const {
        const long L = (long)i * G + c; if (L >= nwg) return false;
        int wgid = (int)L; { const int q = nwg / NXCD, r = nwg % NXCD, xcd = wgid % NXCD, off = wgid / NXCD; wgid = (xcd < r ? xcd * (q + 1) : r * (q + 1) + (xcd - r) * q) + off; }
        const int nig = WGM * nN, gid = wgid / nig, fm = gid * WGM, gsz = (nM - fm) < WGM ? (nM - fm) : WGM;
        u.pm = fm + ((wgid % nig) % gsz); u.pn = (wgid % nig) / gsz; u.k0 = 0; u.nt = ntk; u.pl = nullptr; return true;
    }
    __device__ __forceinline__ void a_ready(const Unit&) const {}
    __device__ __forceinline__ void done(const Unit&) const {}
};

__device__ __forceinline__ unsigned cvt_pk_bf16(float lo, float hi) { unsigned r; asm volatile("v_cvt_pk_bf16_f32 %0, %1, %2" : "=v"(r) : "v"(lo), "v"(hi)); return r; }
typedef float f32x2 __attribute__((ext_vector_type(2)));
template <int ACT, bool STATS> struct EpiMk {
    static constexpr bool PERM = true, AFTER_DRAIN = false;
    bf16_t* O; int ldc; float* ss;
    __device__ __forceinline__ void operator()(const f32x4 (&acc)[2][2][4][2], const Unit& u, int wr, int wc, int fr, int fq) const {
        const int row0 = u.pm * BM + wr * 64 + fr; const int col0 = u.pn * BM + wc * 32 + 8 * fq;
#pragma unroll
        for (int ai = 0; ai < 2; ++ai)
#pragma unroll
            for (int m = 0; m < 4; ++m) { const int row = row0 + ai * HALF + m * 16; bf16_t* rowp = O + (size_t)row * ldc + col0; float s = 0.f;
#pragma unroll
                for (int bj = 0; bj < 2; ++bj) { f32x4 v0 = acc[ai][bj][m][0], v1 = acc[ai][bj][m][1];
                    if (ACT == 1) {
#pragma unroll
                        for (int e = 0; e < 4; ++e) { const float a = fmaxf(v0[e], 0.f), b = fmaxf(v1[e], 0.f); v0[e] = a * a; v1[e] = b * b; } }
                    if (STATS) s += (v0[0] * v0[0] + v0[1] * v0[1]) + (v0[2] * v0[2] + v0[3] * v0[3]) + (v1[0] * v1[0] + v1[1] * v1[1]) + (v1[2] * v1[2] + v1[3] * v1[3]);
                    u32x4 w; w.x = cvt_pk_bf16(v0[0], v0[1]); w.y = cvt_pk_bf16(v0[2], v0[3]); w.z = cvt_pk_bf16(v1[0], v1[1]); w.w = cvt_pk_bf16(v1[2], v1[3]);
                    *(u32x4*)(rowp + bj * HALF) = w; }
                if (STATS) { s += __shfl_xor(s, 16); s += __shfl_xor(s, 32); if (fq == 0) ss[(size_t)row * 16 + u.pn * 4 + wc] = s; } }
    }
};

struct SplitOrder {
    int j0, jstride, nsub, nsplit, npn, ksub; float* pa; size_t pstride; int scut; float* pb;
    __device__ __forceinline__ bool next(int i, Unit& u) const { const int jj = j0 + i * jstride; if (j0 < 0 || jj >= nsub) return false; const int unit = jj / nsplit, s = jj % nsplit;
        u.pm = 64 + unit / npn; u.pn = unit % npn; u.k0 = s * ksub; u.nt = ksub / BK; u.pl = s < scut ? pa + (size_t)s * pstride : pb; return true; }
    __device__ __forceinline__ void a_ready(const Unit&) const {}
    __device__ __forceinline__ void done(const Unit&) const {}
};
struct EpiPlane {
    static constexpr bool PERM = true, AFTER_DRAIN = false; int ldp;
    __device__ __forceinline__ void operator()(const f32x4 (&acc)[2][2][4][2], const Unit& u, int wr, int wc, int fr, int fq) const {
        const int row0 = (u.pm - 64) * BM + wr * 64 + fr; const int col0 = u.pn * BM + wc * 32 + 8 * fq;
#pragma unroll
        for (int ai = 0; ai < 2; ++ai)
#pragma unroll
            for (int m = 0; m < 4; ++m) { float* rowp = u.pl + (size_t)(row0 + ai * HALF + m * 16) * ldp + col0;
#pragma unroll
                for (int bj = 0; bj < 2; ++bj) { *(f32x4*)(rowp + bj * HALF) = acc[ai][bj][m][0]; *(f32x4*)(rowp + bj * HALF + 4) = acc[ai][bj][m][1]; } }
    }
};

template <class Epi, class Sched, bool ALIGN_EPI = false, bool SP2 = false>
__device__ __forceinline__ void gemm_phase(PG8_LAS unsigned char* lds, const Gemm g, const Sched& S, const Epi& E) {
    const int tid = threadIdx.x, wid = __builtin_amdgcn_readfirstlane(tid >> 6), lane = tid & 63, wr = wid >> 2, wc = wid & 3, fr = lane & 15, fq = lane >> 4;
    const int K = g.K;
    unsigned voffA[2], voffB[2];
#pragma unroll
    for (int i = 0; i < 2; ++i) { int R, C; stage_rc(tid * 16 + i * 8192, R, C); const int Rb = Epi::PERM ? ((R & ~31) + perm32(R & 31)) : R;
        voffA[i] = (unsigned)(R * K + C) * 2u; voffB[i] = (unsigned)(Rb * K + C) * 2u; }
    const size_t kstep = (size_t)(BK * 2);
    const size_t hstep = (size_t)HALF * K * 2;
    const size_t tstep = 2 * hstep;
    const unsigned ldsw = (unsigned)wid * 1024u;
    const int aoff = lds_byte(wr * 64 + fr, fq * 8), boff = lds_byte(wc * 32 + fr, fq * 8);
#define PG8_SA(b, h) (((b) * 2 + (h)) * HTB)
#define PG8_SB(b, h) ((4 + (b) * 2 + (h)) * HTB)
#define PG8_STAGE(bufoff, gbase, voff) do { _Pragma("unroll") for (int _i = 0; _i < 2; ++_i) \
        __builtin_amdgcn_global_load_lds((const unsigned*)((const char*)(gbase) + (voff)[_i]), (PG8_LAS unsigned*)(lds + (bufoff) + ldsw + _i * 8192), 16, 0, 0); } while (0)
#define PG8_LDA(dst, b, h) do { _Pragma("unroll") for (int m = 0; m < 4; ++m) _Pragma("unroll") for (int k = 0; k < 2; ++k) dst[m][k] = *(const PG8_LAS bf16x8*)(lds + PG8_SA(b, h) + aoff + m * 2048 + k * 1024); } while (0)
#define PG8_LDB(dst, b, h) do { _Pragma("unroll") for (int n = 0; n < 2; ++n) _Pragma("unroll") for (int k = 0; k < 2; ++k) dst[n][k] = *(const PG8_LAS bf16x8*)(lds + PG8_SB(b, h) + boff + n * 2048 + k * 1024); } while (0)
#define PG8_MMA(ai, bj, At, Bt) do { __builtin_amdgcn_s_setprio(1); _Pragma("unroll") for (int m = 0; m < 4; ++m) _Pragma("unroll") for (int n = 0; n < 2; ++n) _Pragma("unroll") for (int k = 0; k < 2; ++k) \
        acc[ai][bj][m][n] = __builtin_amdgcn_mfma_f32_16x16x32_bf16(Bt[n][k], At[m][k], acc[ai][bj][m][n], 0, 0, 0); __builtin_amdgcn_s_setprio(0); } while (0)
#define PG8_WAIT_V(n) asm volatile("s_waitcnt vmcnt(" #n ")" ::: "memory")
#define PG8_WAIT_L(n) asm volatile("s_waitcnt lgkmcnt(" #n ")" ::: "memory")
#define PG8_BAR __builtin_amdgcn_s_barrier()
#define PG8_SCHED __builtin_amdgcn_sched_barrier(0)
    Unit cur, nxt; int ui = 0;
    if (!S.next(0, cur)) return;
    const int nt = cur.nt;
    f32x4 acc[2][2][4][2];
#pragma unroll
    for (int a = 0; a < 2; ++a)
#pragma unroll
        for (int b = 0; b < 2; ++b)
#pragma unroll
            for (int m = 0; m < 4; ++m)
#pragma unroll
                for (int n = 0; n < 2; ++n) acc[a][b][m][n] = (f32x4){0.f, 0.f, 0.f, 0.f};
    bf16x8 At[4][2], B0[2][2], B1[2][2];
    const char* cA = (const char*)g.A + (size_t)cur.pm * tstep + (size_t)cur.k0 * 2; const char* cB = (const char*)g.Bt + (size_t)cur.pn * tstep + (size_t)cur.k0 * 2;
    S.a_ready(cur);
    if constexpr (SP2) {
        PG8_STAGE(PG8_SB(0, 0), cB, voffB); PG8_STAGE(PG8_SB(0, 1), cB + hstep, voffB); PG8_STAGE(PG8_SA(0, 0), cA, voffA); PG8_STAGE(PG8_SA(0, 1), cA + hstep, voffA);
        if (wr == 1) PG8_BAR;
        PG8_WAIT_V(2); PG8_BAR;
        PG8_STAGE(PG8_SB(1, 0), cB + kstep, voffB); PG8_STAGE(PG8_SA(1, 0), cA + kstep, voffA); PG8_STAGE(PG8_SB(1, 1), cB + hstep + kstep, voffB);
        PG8_WAIT_V(6); PG8_BAR;
    } else {
        PG8_STAGE(PG8_SB(0, 0), cB, voffB); PG8_STAGE(PG8_SA(0, 0), cA, voffA); PG8_STAGE(PG8_SB(0, 1), cB + hstep, voffB); PG8_STAGE(PG8_SA(0, 1), cA + hstep, voffA);
        if (wr == 1) PG8_BAR;
        PG8_WAIT_V(4); PG8_BAR;
        PG8_STAGE(PG8_SB(1, 0), cB + kstep, voffB); PG8_STAGE(PG8_SA(1, 0), cA + kstep, voffA); PG8_STAGE(PG8_SB(1, 1), cB + hstep + kstep, voffB);
        PG8_WAIT_V(6); PG8_BAR;
    }
    for (;;) {
        const bool has_next = S.next(ui + 1, nxt);
        const char* nA = has_next ? (const char*)g.A + (size_t)nxt.pm * tstep + (size_t)nxt.k0 * 2 : cA; const char* nB = has_next ? (const char*)g.Bt + (size_t)nxt.pn * tstep + (size_t)nxt.k0 * 2 : cB;
        for (int t = 0; t < nt; t += 2) {
            const bool last = (t == nt - 2);
            const char* a1 = cA + (size_t)(t + 1) * kstep;
            const char* a2 = last ? nA : cA + (size_t)(t + 2) * kstep; const char* b2 = last ? nB : cB + (size_t)(t + 2) * kstep;
            const char* a3 = a2 + kstep; const char* b3 = b2 + kstep;
            if (last && has_next) S.a_ready(nxt);
            if constexpr (SP2) {
            PG8_LDB(B0, 0, 0); PG8_LDB(B1, 0, 1); PG8_SCHED; PG8_LDA(At, 0, 0); PG8_STAGE(PG8_SA(1, 1), a1 + hstep, voffA);
            PG8_WAIT_V(8); PG8_WAIT_L(0); PG8_BAR; PG8_MMA(0, 0, At, B0); PG8_MMA(0, 1, At, B1); PG8_BAR; PG8_SCHED;
            PG8_LDA(At, 0, 1); PG8_STAGE(PG8_SB(0, 0), b2, voffB); PG8_STAGE(PG8_SB(0, 1), b2 + hstep, voffB); PG8_STAGE(PG8_SA(0, 0), a2, voffA);
            PG8_WAIT_V(8); PG8_WAIT_L(0); PG8_BAR; PG8_MMA(1, 0, At, B0); PG8_MMA(1, 1, At, B1); PG8_BAR; PG8_SCHED;
            PG8_LDB(B0, 1, 0); PG8_LDB(B1, 1, 1); PG8_SCHED; PG8_LDA(At, 1, 0); PG8_STAGE(PG8_SA(0, 1), a2 + hstep, voffA);
            PG8_WAIT_V(8); PG8_WAIT_L(0); PG8_BAR; PG8_MMA(0, 0, At, B0); PG8_MMA(0, 1, At, B1); PG8_BAR; PG8_SCHED;
            PG8_LDA(At, 1, 1); PG8_STAGE(PG8_SB(1, 0), b3, voffB); PG8_STAGE(PG8_SB(1, 1), b3 + hstep, voffB); PG8_STAGE(PG8_SA(1, 0), a3, voffA);
            PG8_WAIT_V(8); PG8_WAIT_L(0); PG8_BAR; PG8_MMA(1, 0, At, B0); PG8_MMA(1, 1, At, B1); PG8_BAR; PG8_SCHED;
            } else {
            PG8_LDB(B0, 0, 0); PG8_SCHED; PG8_LDA(At, 0, 0); PG8_STAGE(PG8_SA(1, 1), a1 + hstep, voffA);
            PG8_WAIT_L(8); PG8_BAR; PG8_WAIT_L(0); PG8_MMA(0, 0, At, B0); PG8_BAR; PG8_SCHED;
            PG8_LDB(B1, 0, 1); PG8_STAGE(PG8_SB(0, 0), b2, voffB);
            PG8_BAR; PG8_WAIT_L(0); PG8_MMA(0, 1, At, B1); PG8_BAR;
            PG8_LDA(At, 0, 1); PG8_STAGE(PG8_SA(0, 0), a2, voffA);
            PG8_BAR; PG8_WAIT_L(0); PG8_MMA(1, 0, At, B0); PG8_BAR; PG8_SCHED;
            PG8_STAGE(PG8_SB(0, 1), b2 + hstep, voffB);
            PG8_WAIT_V(6); PG8_BAR; PG8_MMA(1, 1, At, B1); PG8_BAR;
            PG8_LDB(B0, 1, 0); PG8_SCHED; PG8_LDA(At, 1, 0); PG8_STAGE(PG8_SA(0, 1), a2 + hstep, voffA);
            PG8_WAIT_L(8); PG8_BAR; PG8_WAIT_L(0); PG8_MMA(0, 0, At, B0); PG8_BAR; PG8_SCHED;
            PG8_LDB(B1, 1, 1); PG8_STAGE(PG8_SB(1, 0), b3, voffB);
            PG8_BAR; PG8_WAIT_L(0); PG8_MMA(0, 1, At, B1); PG8_BAR;
            PG8_LDA(At, 1, 1); PG8_STAGE(PG8_SA(1, 0), a3, voffA);
            PG8_BAR; PG8_WAIT_L(0); PG8_MMA(1, 0, At, B0); PG8_BAR; PG8_SCHED;
            PG8_STAGE(PG8_SB(1, 1), b3 + hstep, voffB);
            PG8_WAIT_V(6); PG8_BAR; PG8_MMA(1, 1, At, B1); PG8_BAR;
            }
        }
        if constexpr (ALIGN_EPI) { if (wr == 0) PG8_BAR; }
        if constexpr (!Epi::AFTER_DRAIN) { E(acc, cur, wr, wc, fr, fq); S.done(cur); }
        if (!has_next) break;
#pragma unroll
        for (int a = 0; a < 2; ++a)
#pragma unroll
            for (int b = 0; b < 2; ++b)
#pragma unroll
                for (int m = 0; m < 4; ++m)
#pragma unroll
                    for (int n = 0; n < 2; ++n) acc[a][b][m][n] = (f32x4){0.f, 0.f, 0.f, 0.f};
        cur = nxt; cA = nA; cB = nB; ++ui;
        if constexpr (ALIGN_EPI) { if (wr == 1) PG8_BAR; }
    }
    PG8_WAIT_V(0);
    if constexpr (!ALIGN_EPI) { if (wr == 0) PG8_BAR; }
    PG8_BAR;
    if constexpr (Epi::AFTER_DRAIN) { E.fused(acc, cur, wr, wc, fr, fq, lds, wid, lane); S.done(cur); }
#undef PG8_SA
#undef PG8_SB
#undef PG8_STAGE
#undef PG8_LDA
#undef PG8_LDB
#undef PG8_MMA
#undef PG8_WAIT_V
#undef PG8_WAIT_L
#undef PG8_BAR
#undef PG8_SCHED
}
}
#define GAS __attribute__((address_space(1)))
#define LAS __attribute__((address_space(3)))
typedef unsigned short bf16;
typedef unsigned v4u __attribute__((ext_vector_type(4)));
typedef float f32x4 __attribute__((ext_vector_type(4)));
typedef short bf16x8 __attribute__((ext_vector_type(8)));
typedef GAS unsigned gu32;
typedef GAS unsigned long long gu64;
#define RLX_AGENT __ATOMIC_RELAXED, __HIP_MEMORY_SCOPE_AGENT
#define LDS_WAIT() asm volatile("s_waitcnt lgkmcnt(0)" ::: "memory")
#define VM_WAIT() asm volatile("s_waitcnt vmcnt(0)" ::: "memory")
__device__ __forceinline__ unsigned long long rt() { return __builtin_amdgcn_s_memrealtime(); }
__device__ __forceinline__ unsigned f2bf(float f) { unsigned u = __builtin_bit_cast(unsigned, f); return (u + 0x7fffu + ((u >> 16) & 1u)) >> 16; }
__device__ __forceinline__ unsigned pk2(float lo, float hi) { return f2bf(lo) | (f2bf(hi) << 16); }

#define XB_TMO      128
#define XB_XCNT(j)  (256  + 64 * (j))
#define XB_XSUB(j)  (1280 + 64 * (j))
#define XB_XGEN(j)  (2304 + 64 * (j))
#define XB_TOP      3328
#define XB_TOPGEN   3392
#define XCD_BAR_WORDS 3456
#define XB_SPIN_CAP (1u << 18)

__device__ __forceinline__ unsigned xb_ld(unsigned* p)              { return __hip_atomic_load(p, __ATOMIC_RELAXED, __HIP_MEMORY_SCOPE_AGENT); }
__device__ __forceinline__ unsigned xb_add(unsigned* p, unsigned v) { return __hip_atomic_fetch_add(p, v, __ATOMIC_RELAXED, __HIP_MEMORY_SCOPE_AGENT); }
__device__ __forceinline__ unsigned xb_xcc_id() { return (unsigned)__builtin_amdgcn_s_getreg((3 << 11) | 20) & 0xFu; }
#define XB_SPIN(cond, bar) do { unsigned _sp = 0; while (cond) { __builtin_amdgcn_s_sleep(1); \
    if ((++_sp & 255u) == 0u) { if (xb_ld(&(bar)[XB_TMO])) break; if (_sp > XB_SPIN_CAP) { atomicAdd(&(bar)[XB_TMO], 1u); break; } } } } while (0)

struct XcdBarrier {
    unsigned* bar; unsigned x;
    volatile LAS unsigned* st;
};

__device__ __forceinline__ XcdBarrier xcd_barrier_post(unsigned* bar, volatile LAS unsigned* st) {
    XcdBarrier b; b.bar = bar; b.x = xb_xcc_id(); b.st = st;
    if (threadIdx.x == 0) (void)xb_add(&bar[XB_XCNT(b.x)], 1u);
    return b;
}
__device__ __forceinline__ void xcd_barrier_complete(unsigned* bar, unsigned x, unsigned& nloc, unsigned& nx) {
    const unsigned G = gridDim.x * gridDim.y * gridDim.z;
    unsigned sum, cnt, mine, sp = 0u;
    for (;;) {
        sum = 0u; cnt = 0u; mine = 0u;
#pragma unroll
        for (unsigned j = 0; j < 16; ++j) { const unsigned c = xb_ld(&bar[XB_XCNT(j)]); sum += c; cnt += (c > 0u) ? 1u : 0u; mine = (j == x) ? c : mine; }
        if (sum == G) break;
        __builtin_amdgcn_s_sleep(1);
        if ((++sp & 255u) == 0u) { if (xb_ld(&bar[XB_TMO])) break; if (sp > XB_SPIN_CAP) { atomicAdd(&bar[XB_TMO], 1u); break; } }
    }
    nloc = mine > 0u ? mine : 1u; nx = cnt > 0u ? cnt : 1u;
}

__device__ __forceinline__ void xcd_barrier(const XcdBarrier& b) {
    asm volatile("s_waitcnt vmcnt(0)" ::: "memory");
    __syncthreads();
    if (threadIdx.x == 0) {
        unsigned* bar = b.bar;
        __builtin_amdgcn_s_waitcnt(0);
        unsigned nloc = b.st[0], nx = b.st[1];
        if (nloc == 0u) { xcd_barrier_complete(bar, b.x, nloc, nx); b.st[0] = nloc; b.st[1] = nx; }
        const unsigned old = xb_add(&bar[XB_XSUB(b.x)], 1u);
        const unsigned gen = old / nloc;
        if (old + 1u == (gen + 1u) * nloc) {
            __builtin_amdgcn_fence(__ATOMIC_RELEASE, "agent");
            asm volatile("s_waitcnt vmcnt(0)" ::: "memory");
            const unsigned og = xb_add(&bar[XB_TOP], 1u);
            const unsigned tg = og / nx;
            if (og + 1u == (tg + 1u) * nx) xb_add(&bar[XB_TOPGEN], 1u);
            else XB_SPIN(xb_ld(&bar[XB_TOPGEN]) == tg, bar);
            __builtin_amdgcn_fence(__ATOMIC_ACQUIRE, "agent");
            xb_add(&bar[XB_XGEN(b.x)], 1u);
            asm volatile("s_waitcnt vmcnt(0)" ::: "memory");
        } else {
            XB_SPIN(xb_ld(&bar[XB_XGEN(b.x)]) == gen, bar);
            __builtin_amdgcn_fence(__ATOMIC_ACQUIRE, "agent");
            asm volatile("s_waitcnt vmcnt(0)" ::: "memory");
        }
    }
    __syncthreads();
}
#ifndef MK_N_LAUNCHES
#define MK_N_LAUNCHES 1
#endif
constexpr int DM = 1024, NPR = 16384, NSR = 1024, MR = NPR + NSR, SEQ = 8192, NPJ = 2560, FF = 4096, WIN_LD = 2320;
constexpr int C_Q = 0, C_K = 512, C_V = 640, C_GQ = 768, C_GK = 1024, C_GV = 1280, C_GR = 1792, C_Z = 2304;
constexpr float EPSN = 1e-6f, LOG2E = 1.4426950408889634f;
constexpr size_t O_YP = 0, O_YS = 16777216, O_KWP = 17825792, O_VWP = O_KWP + 32768, O_GLP = O_VWP + 32768, O_KWS = O_GLP + 65536, O_VWS = O_KWS + 2097152, O_GLS = O_VWS + 2097152;
constexpr size_t MiB = 1u << 20;
constexpr size_t WS_CTL = 0, CTL_ZERO_BYTES = 64 * 1024;
constexpr size_t WS_WDN = 1 * MiB, WS_WIN = 9 * MiB, WS_WOUT = 14 * MiB, WS_WUP = 16 * MiB;
constexpr size_t WS_XN = 24 * MiB, WS_PROJ = 58 * MiB, WS_MIX = 143 * MiB, WS_ST = 177 * MiB, WS_ABLK = 209 * MiB, WS_ROPE = 210 * MiB, WS_SS = 254 * MiB;
constexpr size_t WS_OPL = 24 * MiB, WS_UPL_A = 92 * MiB, WS_UPL_B = 194 * MiB, WS_DPL_A = 194 * MiB, WS_DPL_B = 9 * MiB;
constexpr size_t WS_MIXOUT = 58 * MiB, WS_U = 58 * MiB, WS_F = 24 * MiB, WS_END = 256 * MiB;
constexpr int CW_BAR = 1024;
constexpr int RING_BYTES = 131072, MISC_OFF = RING_BYTES, LDS_BYTES = RING_BYTES + 1024;
constexpr int NPH = 10;

typedef short s16x4 __attribute__((ext_vector_type(4)));
typedef unsigned u32x2 __attribute__((ext_vector_type(2)));
typedef float f32x2v __attribute__((ext_vector_type(2)));
typedef __bf16 bf16x2_t __attribute__((ext_vector_type(2)));
__device__ __forceinline__ unsigned pkbf(float lo, float hi) { f32x2v v = {lo, hi}; bf16x2_t b = __builtin_convertvector(v, bf16x2_t); return __builtin_bit_cast(unsigned, b); }
__device__ __forceinline__ float bflo(unsigned w) { return __uint_as_float(w << 16); }
__device__ __forceinline__ float bfhi(unsigned w) { return __uint_as_float(w & 0xffff0000u); }
__device__ __forceinline__ float bf2f(bf16 b) { return __uint_as_float((unsigned)b << 16); }
__device__ __forceinline__ float wave_sum(float v) {
#pragma unroll
    for (int o = 1; o < 64; o <<= 1) v += __shfl_xor(v, o);
    return v;
}
__device__ __forceinline__ f32x4 mfma16(bf16x8 a, bf16x8 b, f32x4 c) { return __builtin_amdgcn_mfma_f32_16x16x32_bf16(a, b, c, 0, 0, 0); }
__device__ __forceinline__ float logsig16(float z) { return (fminf(z, 0.f) - __logf(1.f + __expf(-fabsf(z)))) * 0.0625f; }

struct Args { const float* in[17]; float* out; unsigned char* ws; double inv_freq[32]; int ph_lo, ph_hi, never, use_bar; };
enum { I_XP = 0, I_XS, I_CK, I_CV, I_SG, I_WIN, I_WGK2, I_BGK, I_GGLA, I_SINK, I_WOUT, I_GMPRE, I_GMPOST, I_GFPRE, I_GFPOST, I_WUP, I_WDN };

__device__ __forceinline__ void p0_transpose_item(const float* W, int ldw, int nblk, int K, bf16* WT, LAS float* scr, int item, int lane) {
    const int kb = item / nblk, nb = item % nblk, k0 = 64 * kb, n0 = 32 * nb;
#pragma unroll 8
    for (int i = 0; i < 32; ++i) { const int kk = 2 * i + (lane >> 5); scr[kk * 33 + (lane & 31)] = W[(size_t)(k0 + kk) * ldw + n0 + (lane & 31)]; }
    LDS_WAIT(); asm volatile("" ::: "memory");
    const int c = lane & 7;
#pragma unroll
    for (int j = 0; j < 4; ++j) { const int n = (lane >> 3) + 8 * j; const LAS float* s = scr + (8 * c) * 33 + n;
        v4u o; o.x = pkbf(s[0 * 33], s[1 * 33]); o.y = pkbf(s[2 * 33], s[3 * 33]); o.z = pkbf(s[4 * 33], s[5 * 33]); o.w = pkbf(s[6 * 33], s[7 * 33]);
        *(v4u*)(WT + (size_t)(n0 + n) * K + k0 + 8 * c) = o; }
    LDS_WAIT(); asm volatile("" ::: "memory");
}
__device__ __forceinline__ const float* xrow_ptr(const Args& a, int m) { return m < NPR ? a.in[I_XP] + (size_t)m * DM : a.in[I_XS] + (size_t)(m - NPR) * DM; }

__device__ __forceinline__ void phase0(const Args& a, LAS unsigned char* L, int G, int bid, int tid, int lane, int wave) {
    unsigned char* ws = a.ws;
    bf16* Win_t = (bf16*)(ws + WS_WIN); bf16* Wout_t = (bf16*)(ws + WS_WOUT); bf16* Wup_t = (bf16*)(ws + WS_WUP); bf16* Wdn_t = (bf16*)(ws + WS_WDN);
    const int gw = bid * 8 + wave, NGW = G * 8;
    LAS float* scr = (LAS float*)(L + wave * 16384);
    constexpr int I_IN = 16 * 72, I_OUT = 16 * 32, I_UP = 16 * 128, I_DN = 64 * 32, NITEMS = I_IN + I_OUT + I_UP + I_DN;
    for (int it = gw; it < NITEMS; it += NGW) {
        int r = it;
        if (r < I_IN) { p0_transpose_item(a.in[I_WIN], WIN_LD, 72, DM, Win_t, scr, r, lane); continue; } r -= I_IN;
        if (r < I_OUT) { p0_transpose_item(a.in[I_WOUT], DM, 32, DM, Wout_t, scr, r, lane); continue; } r -= I_OUT;
        if (r < I_UP) { p0_transpose_item(a.in[I_WUP], FF, 128, DM, Wup_t, scr, r, lane); continue; } r -= I_UP;
        p0_transpose_item(a.in[I_WDN], DM, 32, FF, Wdn_t, scr, r, lane);
    }
    const int gt = bid * 512 + tid, NGT = G * 512;
    for (int e = gt; e < 256 * 1024; e += NGT) { const int j = e >> 10, k = e & 1023; const float* wr = a.in[I_WIN] + (size_t)k * WIN_LD + 2304; const float* g2 = a.in[I_WGK2] + j;
        float s = 0.f;
#pragma unroll
        for (int r = 0; r < 16; ++r) s += wr[r] * g2[r * 256];
        Win_t[(size_t)(2304 + j) * DM + k] = (bf16)(pkbf(s, 0.f) & 0xffffu); }
    f32x2v* rope = (f32x2v*)(ws + WS_ROPE);
    for (int e = gt; e < 8200 * 32; e += NGT) { const int pidx = e >> 5, i = e & 31; const int pos = pidx < 8192 ? pidx : 16384 + pidx - 8192;
        const double ang = (double)pos * a.inv_freq[i]; const double q = rint(ang * 0.15915494309189535);
        double r = fma(-q, 6.283185307179586, ang); r = fma(-q, 2.4492935982947064e-16, r);
        const float rf = (float)r; rope[e] = (f32x2v){__cosf(rf), __sinf(rf)}; }
    bf16* XN = (bf16*)(ws + WS_XN); const float* g = a.in[I_GMPRE];
    for (int m = gw; m < MR; m += NGW) { const f32x4* xr = (const f32x4*)xrow_ptr(a, m) + lane; f32x4 v[4]; float s = 0.f;
#pragma unroll
        for (int j = 0; j < 4; ++j) { v[j] = xr[64 * j]; s += (v[j].x * v[j].x + v[j].y * v[j].y) + (v[j].z * v[j].z + v[j].w * v[j].w); }
        const float rstd = rsqrtf(wave_sum(s) * (1.f / DM) + EPSN);
        u32x2* o8 = (u32x2*)(XN + (size_t)m * DM) + lane;
#pragma unroll
        for (int j = 0; j < 4; ++j) { const f32x4 gg = ((const f32x4*)g)[lane + 64 * j]; o8[64 * j] = (u32x2){pkbf(v[j].x * rstd * gg.x, v[j].y * rstd * gg.y), pkbf(v[j].z * rstd * gg.z, v[j].w * rstd * gg.w)}; }
    }
}
constexpr int KROW = 144, VROW = 528, LDS_VT = 256 * KROW;
__device__ __forceinline__ void rope_half_row(const bf16* src, const f32x2v* tb, LAS unsigned char* dst, float* outf) {
    const v4u a0 = *(const v4u*)src, a1 = *(const v4u*)(src + 8), b0 = *(const v4u*)(src + 32), b1 = *(const v4u*)(src + 40);
    const unsigned w1[8] = {a0.x, a0.y, a0.z, a0.w, a1.x, a1.y, a1.z, a1.w}, w2[8] = {b0.x, b0.y, b0.z, b0.w, b1.x, b1.y, b1.z, b1.w};
    unsigned r1[8], r2[8];
#pragma unroll
    for (int i = 0; i < 8; ++i) { const f32x2v c0 = tb[2 * i], c1 = tb[2 * i + 1];
        const float x1a = bflo(w1[i]), x1b = bfhi(w1[i]), x2a = bflo(w2[i]), x2b = bfhi(w2[i]);
        const float y1a = x1a * c0.x - x2a * c0.y, y2a = x2a * c0.x + x1a * c0.y, y1b = x1b * c1.x - x2b * c1.y, y2b = x2b * c1.x + x1b * c1.y;
        r1[i] = pkbf(y1a, y1b); r2[i] = pkbf(y2a, y2b);
        if (outf) { outf[2 * i] = y1a; outf[2 * i + 1] = y1b; outf[32 + 2 * i] = y2a; outf[32 + 2 * i + 1] = y2b; } }
    *(LAS v4u*)dst = (v4u){r1[0], r1[1], r1[2], r1[3]}; *(LAS v4u*)(dst + 16) = (v4u){r1[4], r1[5], r1[6], r1[7]};
    *(LAS v4u*)(dst + 64) = (v4u){r2[0], r2[1], r2[2], r2[3]}; *(LAS v4u*)(dst + 80) = (v4u){r2[4], r2[5], r2[6], r2[7]};
}
__device__ __forceinline__ void vt_half_row(const bf16* src, LAS unsigned char* vt_col  , float* outf) {
#pragma unroll
    for (int c = 0; c < 4; ++c) { const v4u w = *(const v4u*)(src + 8 * c); const unsigned ww[4] = {w.x, w.y, w.z, w.w};
#pragma unroll
        for (int i = 0; i < 4; ++i) { const int d = 8 * c + 2 * i;
            *(LAS unsigned short*)(vt_col + d * VROW) = (unsigned short)(ww[i] & 0xffffu); *(LAS unsigned short*)(vt_col + (d + 1) * VROW) = (unsigned short)(ww[i] >> 16);
            if (outf) { outf[d] = bflo(ww[i]); outf[d + 1] = bfhi(ww[i]); } } }
}
__device__ __forceinline__ void load_q_frags(const bf16* src, const f32x2v* tb, bf16x8& q0, bf16x8& q1) {
    const v4u a = *(const v4u*)src, b = *(const v4u*)(src + 32); const unsigned w1[4] = {a.x, a.y, a.z, a.w}, w2[4] = {b.x, b.y, b.z, b.w}; unsigned r1[4], r2[4];
#pragma unroll
    for (int i = 0; i < 4; ++i) { const f32x2v c0 = tb[2 * i], c1 = tb[2 * i + 1];
        const float x1a = bflo(w1[i]), x1b = bfhi(w1[i]), x2a = bflo(w2[i]), x2b = bfhi(w2[i]);
        r1[i] = pkbf(x1a * c0.x - x2a * c0.y, x1b * c1.x - x2b * c1.y); r2[i] = pkbf(x2a * c0.x + x1a * c0.y, x2b * c1.x + x1b * c1.y); }
    q0 = __builtin_bit_cast(bf16x8, (v4u){r1[0], r1[1], r1[2], r1[3]}); q1 = __builtin_bit_cast(bf16x8, (v4u){r2[0], r2[1], r2[2], r2[3]});
}
template <bool SAMPLE> __device__ __forceinline__ void attn_qtile(LAS unsigned char* Ks, LAS unsigned char* Vt, bf16x8 q0, bf16x8 q1, int kt0, float sink2, int l15, int fq, bool first, int qt, bf16* outp) {
    f32x4 s[9];
#pragma unroll
    for (int r = 0; r < 9; ++r) { LAS unsigned char* kp = Ks + ((kt0 + r) * 16 + l15) * KROW + fq * 16;
        const bf16x8 k0 = *(LAS bf16x8*)kp, k1 = *(LAS bf16x8*)(kp + 64);
        f32x4 a = {0.f, 0.f, 0.f, 0.f}; a = mfma16(k0, q0, a); a = mfma16(k1, q1, a); s[r] = a; }
    const float C2 = 0.125f * LOG2E; float mx = -INFINITY;
#pragma unroll
    for (int r = 0; r < 9; ++r)
#pragma unroll
        for (int j = 0; j < 4; ++j) { bool ok;
            if (SAMPLE) { const int kidx = r * 16 + fq * 4 + j, t = l15 & 7; ok = (kidx > t) && (kidx <= t + 128); }
            else { ok = true; if (r == 0) ok = l15 < fq * 4 + j; if (r == 8) ok = l15 >= fq * 4 + j; if (first && (qt + r < 8)) ok = false; }
            const float v = ok ? s[r][j] * C2 : -INFINITY; s[r][j] = v; mx = fmaxf(mx, v); }
    mx = fmaxf(mx, __shfl_xor(mx, 16)); mx = fmaxf(mx, __shfl_xor(mx, 32));
    const float m = fmaxf(mx, sink2); float sum = 0.f;
#pragma unroll
    for (int r = 0; r < 9; ++r)
#pragma unroll
        for (int j = 0; j < 4; ++j) { const float p = __builtin_amdgcn_exp2f(s[r][j] - m); s[r][j] = p; sum += p; }
    sum += __shfl_xor(sum, 16); sum += __shfl_xor(sum, 32);
    const float inv = 1.f / (sum + __builtin_amdgcn_exp2f(sink2 - m));
    f32x4 o[4];
#pragma unroll
    for (int dt = 0; dt < 4; ++dt) o[dt] = (f32x4){0.f, 0.f, 0.f, 0.f};
#pragma unroll
    for (int c = 0; c < 5; ++c) {
        v4u pw; pw.x = pkbf(s[2 * c][0], s[2 * c][1]); pw.y = pkbf(s[2 * c][2], s[2 * c][3]);
        if (c < 4) { pw.z = pkbf(s[2 * c + 1][0], s[2 * c + 1][1]); pw.w = pkbf(s[2 * c + 1][2], s[2 * c + 1][3]); } else { pw.z = 0u; pw.w = 0u; }
        const bf16x8 pf = __builtin_bit_cast(bf16x8, pw);
#pragma unroll
        for (int dt = 0; dt < 4; ++dt) { LAS unsigned char* vp = Vt + (dt * 16 + l15) * VROW + ((kt0 + 2 * c) * 16 + fq * 4) * 2;
            const u32x2 lo = *(LAS u32x2*)vp; u32x2 hi = {0u, 0u}; if (c < 4) hi = *(LAS u32x2*)(vp + 32);
            const bf16x8 vf = __builtin_bit_cast(bf16x8, (v4u){lo.x, lo.y, hi.x, hi.y});
            o[dt] = mfma16(vf, pf, o[dt]); } }
#pragma unroll
    for (int dt = 0; dt < 4; ++dt) *(u32x2*)(outp + dt * 16 + fq * 4) = (u32x2){pkbf(o[dt][0] * inv, o[dt][1] * inv), pkbf(o[dt][2] * inv, o[dt][3] * inv)};
}

__device__ __forceinline__ void attn_prompt_unit(const Args& a, LAS unsigned char* L, int u, int tid, int lane, int wave) {
    const bf16* PROJ = (const bf16*)(a.ws + WS_PROJ); bf16* MIX = (bf16*)(a.ws + WS_MIX); const f32x2v* ROPE = (const f32x2v*)(a.ws + WS_ROPE);
    const int b = u >> 7, n = (u >> 1) & 63, kvh = u & 1;
    LAS unsigned char* Ks = L; LAS unsigned char* Vt = L + LDS_VT;
    __syncthreads();
    { const int key = tid >> 1, hf = tid & 1, kpos = (n - 1) * 128 + key;
      if (kpos >= 0) { const bf16* rowp = PROJ + (size_t)(b * SEQ + kpos) * NPJ; const bool wout = (n == 63) && (key >= 128); const size_t oidx = ((size_t)(b * 128 + key - 128) * 2 + kvh) * 64;
          rope_half_row(rowp + C_K + kvh * 64 + hf * 16, ROPE + (size_t)kpos * 32 + hf * 16, Ks + key * KROW + hf * 32, wout ? a.out + O_KWP + oidx + hf * 16 : nullptr);
          vt_half_row(rowp + C_V + kvh * 64 + hf * 32, Vt + (hf * 32) * VROW + key * 2, wout ? a.out + O_VWP + oidx + hf * 32 : nullptr); }
      else { const v4u z = {0u, 0u, 0u, 0u}; LAS unsigned char* kd = Ks + key * KROW + hf * 32; *(LAS v4u*)kd = z; *(LAS v4u*)(kd + 16) = z; *(LAS v4u*)(kd + 64) = z; *(LAS v4u*)(kd + 80) = z;
#pragma unroll
          for (int d = 0; d < 32; ++d) *(LAS unsigned short*)(Vt + (hf * 32 + d) * VROW + key * 2) = 0; } }
    __syncthreads();
    const int l15 = lane & 15, fq = lane >> 4, g = wave >> 1; const float sink2 = a.in[I_SINK][kvh * 4 + g] * LOG2E;
    for (int i = 0; i < 4; ++i) { const int qt = (wave & 1) * 4 + i, qpos = n * 128 + qt * 16 + l15; const size_t row = (size_t)b * SEQ + qpos;
        bf16x8 q0, q1; load_q_frags(PROJ + row * NPJ + C_Q + (kvh * 4 + g) * 64 + fq * 8, ROPE + (size_t)qpos * 32 + fq * 8, q0, q1);
        attn_qtile<false>(Ks, Vt, q0, q1, qt, sink2, l15, fq, n == 0, qt, MIX + row * DM + (kvh * 4 + g) * 64); }
}

__device__ __forceinline__ void attn_sample_unit(const Args& a, LAS unsigned char* L, int u, int tid, int lane, int wave) {
    const bf16* PROJ = (const bf16*)(a.ws + WS_PROJ); bf16* MIX = (bf16*)(a.ws + WS_MIX); const f32x2v* ROPE = (const f32x2v*)(a.ws + WS_ROPE);
    const int b = u >> 1, kvh = u & 1;
    LAS unsigned char* Ks = L; LAS unsigned char* Vt = L + LDS_VT;
    __syncthreads();
    { const int key = tid >> 2, qd = tid & 3; const size_t ci = ((size_t)(b * 128 + key) * 2 + kvh) * 64 + qd * 16; const f32x4* ck = (const f32x4*)(a.in[I_CK] + ci); const f32x4* cv = (const f32x4*)(a.in[I_CV] + ci);
      f32x4 kv[4], vv[4];
#pragma unroll
      for (int c = 0; c < 4; ++c) { kv[c] = ck[c]; vv[c] = cv[c]; }
      LAS unsigned char* kd = Ks + key * KROW + qd * 32;
      *(LAS v4u*)kd = (v4u){pkbf(kv[0].x, kv[0].y), pkbf(kv[0].z, kv[0].w), pkbf(kv[1].x, kv[1].y), pkbf(kv[1].z, kv[1].w)};
      *(LAS v4u*)(kd + 16) = (v4u){pkbf(kv[2].x, kv[2].y), pkbf(kv[2].z, kv[2].w), pkbf(kv[3].x, kv[3].y), pkbf(kv[3].z, kv[3].w)};
#pragma unroll
      for (int c = 0; c < 4; ++c) { const unsigned p0 = pkbf(vv[c].x, vv[c].y), p1 = pkbf(vv[c].z, vv[c].w); LAS unsigned char* vp = Vt + (qd * 16 + c * 4) * VROW + key * 2;
          *(LAS unsigned short*)vp = (unsigned short)(p0 & 0xffffu); *(LAS unsigned short*)(vp + VROW) = (unsigned short)(p0 >> 16);
          *(LAS unsigned short*)(vp + 2 * VROW) = (unsigned short)(p1 & 0xffffu); *(LAS unsigned short*)(vp + 3 * VROW) = (unsigned short)(p1 >> 16); }
      if (key >= 8) { const size_t oi = ((size_t)(b * 128 + key - 8) * 2 + kvh) * 64 + qd * 16; f32x4* ok = (f32x4*)(a.out + O_KWS + oi); f32x4* ov = (f32x4*)(a.out + O_VWS + oi);
#pragma unroll
          for (int c = 0; c < 4; ++c) { ok[c] = kv[c]; ov[c] = vv[c]; } } }
    if (tid < 16) { const int kk = tid >> 1, hf = tid & 1; const bf16* rowp = PROJ + (size_t)(NPR + b * 8 + kk) * NPJ; const size_t oidx = ((size_t)(b * 128 + 120 + kk) * 2 + kvh) * 64;
        rope_half_row(rowp + C_K + kvh * 64 + hf * 16, ROPE + (size_t)(8192 + kk) * 32 + hf * 16, Ks + (128 + kk) * KROW + hf * 32, a.out + O_KWS + oidx + hf * 16); }
    else if (tid < 32) { const int kk = (tid - 16) >> 1, hf = tid & 1; const bf16* rowp = PROJ + (size_t)(NPR + b * 8 + kk) * NPJ; const size_t oidx = ((size_t)(b * 128 + 120 + kk) * 2 + kvh) * 64;
        vt_half_row(rowp + C_V + kvh * 64 + hf * 32, Vt + (hf * 32) * VROW + (128 + kk) * 2, a.out + O_VWS + oidx + hf * 32); }
    else if (tid >= 64 && tid < 64 + 72) { *(LAS v4u*)(Ks + 136 * KROW + (tid - 64) * 16) = (v4u){0u, 0u, 0u, 0u}; }
    else if (tid >= 192 && tid < 256) { *(LAS v4u*)(Vt + (tid - 192) * VROW + 272) = (v4u){0u, 0u, 0u, 0u}; }
    __syncthreads();
    if (wave < 2) { const int l15 = lane & 15, fq = lane >> 4, g = wave * 2 + (l15 >> 3), t = l15 & 7; const size_t row = (size_t)NPR + b * 8 + t;
        const float sink2 = a.in[I_SINK][kvh * 4 + g] * LOG2E;
        bf16x8 q0, q1; load_q_frags(PROJ + row * NPJ + C_Q + (kvh * 4 + g) * 64 + fq * 8, ROPE + (size_t)(8192 + t) * 32 + fq * 8, q0, q1);
        attn_qtile<true>(Ks, Vt, q0, q1, 0, sink2, l15, fq, false, 0, MIX + row * DM + (kvh * 4 + g) * 64); }
}
constexpr int GROW = 144;
__device__ __forceinline__ void gla_cumsum(const bf16* prow0, int h, const float* b_gk, LAS float* red, int tid, float (&bc)[8], float& blast) {
    const int k = tid & 63, tg = tid >> 6; const float bias = b_gk[h * 64 + k]; float run = 0.f;
#pragma unroll
    for (int i = 0; i < 8; ++i) { const float z = bf2f(prow0[(size_t)(tg * 8 + i) * NPJ + C_Z + h * 64 + k]) + bias; run += logsig16(z); bc[i] = run; }
    red[tg * 64 + k] = run; __syncthreads();
    float pre = 0.f, tot = 0.f;
#pragma unroll
    for (int g = 0; g < 8; ++g) { const float r = red[g * 64 + k]; tot += r; if (g < tg) pre += r; }
#pragma unroll
    for (int i = 0; i < 8; ++i) bc[i] += pre;
    blast = tot;
}
__device__ __forceinline__ void gla_load_vt(const bf16* prow0, int h, LAS unsigned char* VT, int tid) {
    const int v = tid & 127, tq = tid >> 7;
#pragma unroll
    for (int i = 0; i < 8; ++i) { const int t = tq * 16 + 2 * i; const unsigned lo = prow0[(size_t)t * NPJ + C_GV + h * 128 + v], hi = prow0[(size_t)(t + 1) * NPJ + C_GV + h * 128 + v];
        *(LAS unsigned*)(VT + v * GROW + t * 2) = lo | (hi << 16); }
}
__device__ __forceinline__ void gla_local_unit(const Args& a, LAS unsigned char* L, int uid, int tid, int lane, int wave) {
    const int bh = uid >> 7, c = uid & 127, b = bh >> 2, h = bh & 3;
    const bf16* prow0 = (const bf16*)(a.ws + WS_PROJ) + (size_t)(b * SEQ + c * 64) * NPJ;
    LAS unsigned char* KdT = L; LAS unsigned char* VT = L + 64 * GROW; LAS float* red = (LAS float*)(L + 64 * GROW + 128 * GROW);
    __syncthreads();
    float bc[8], blast; gla_cumsum(prow0, h, a.in[I_BGK], red, tid, bc, blast);
    { const int k = tid & 63, tg = tid >> 6; unsigned w[4];
#pragma unroll
      for (int i = 0; i < 4; ++i) { const float k0 = bf2f(prow0[(size_t)(tg * 8 + 2 * i) * NPJ + C_GK + h * 64 + k]) * __expf(blast - bc[2 * i]);
          const float k1 = bf2f(prow0[(size_t)(tg * 8 + 2 * i + 1) * NPJ + C_GK + h * 64 + k]) * __expf(blast - bc[2 * i + 1]); w[i] = pkbf(k0, k1); }
      *(LAS v4u*)(KdT + k * GROW + tg * 16) = (v4u){w[0], w[1], w[2], w[3]};
      if (tg == 0) ((float*)(a.ws + WS_ABLK))[(size_t)uid * 64 + k] = __expf(blast); }
    gla_load_vt(prow0, h, VT, tid);
    __syncthreads();
    const int l15 = lane & 15, fq = lane >> 4, vt = wave;
    bf16x8 vf[2];
#pragma unroll
    for (int ks = 0; ks < 2; ++ks) vf[ks] = *(LAS bf16x8*)(VT + (vt * 16 + l15) * GROW + ks * 64 + fq * 16);
    float* ST = (float*)(a.ws + WS_ST) + (size_t)uid * 8192;
#pragma unroll
    for (int kt = 0; kt < 4; ++kt) { f32x4 acc = {0.f, 0.f, 0.f, 0.f};
#pragma unroll
        for (int ks = 0; ks < 2; ++ks) { const bf16x8 kf = *(LAS bf16x8*)(KdT + (kt * 16 + l15) * GROW + ks * 64 + fq * 16); acc = mfma16(vf[ks], kf, acc); }
#pragma unroll
        for (int j = 0; j < 4; ++j) ST[(vt * 16 + fq * 4 + j) * 64 + kt * 16 + l15] = acc[j]; }
}
__device__ __forceinline__ void gla_scan(const Args& a, int id) {
    const int bh = id >> 13, e = id & 8191, k = e & 63, v = e >> 6;
    float* ST = (float*)(a.ws + WS_ST) + (size_t)bh * 128 * 8192 + e; const float* AB = (const float*)(a.ws + WS_ABLK) + (size_t)bh * 128 * 64 + k;
    float carry = 0.f;
    for (int c0 = 0; c0 < 128; c0 += 8) { float u[8], ab[8];
#pragma unroll
        for (int i = 0; i < 8; ++i) { u[i] = ST[(size_t)(c0 + i) * 8192]; ab[i] = AB[(c0 + i) * 64]; }
#pragma unroll
        for (int i = 0; i < 8; ++i) { ST[(size_t)(c0 + i) * 8192] = carry; carry = ab[i] * carry + u[i]; } }
    a.out[O_GLP + (size_t)bh * 8192 + k * 128 + v] = carry;
}
__device__ __forceinline__ void gla_out_unit(const Args& a, LAS unsigned char* L, int uid, int tid, int lane, int wave) {
    const int bh = uid >> 7, c = uid & 127, b = bh >> 2, h = bh & 3; const size_t row0 = (size_t)b * SEQ + c * 64;
    const bf16* prow0 = (const bf16*)(a.ws + WS_PROJ) + row0 * NPJ;
    LAS unsigned char* Qt = L; LAS unsigned char* Kt = L + 64 * GROW; LAS unsigned char* VT = L + 128 * GROW; LAS float* red = (LAS float*)(L + 256 * GROW); LAS float* nrm = red + 512;
    __syncthreads();
    float bc[8], blast; gla_cumsum(prow0, h, a.in[I_BGK], red, tid, bc, blast);
    { const int k = tid & 63, tg = tid >> 6;
#pragma unroll
      for (int i = 0; i < 8; ++i) { const int t = tg * 8 + i; const float q = bf2f(prow0[(size_t)t * NPJ + C_GQ + h * 64 + k]) * 0.125f * __expf(bc[i]), kk = bf2f(prow0[(size_t)t * NPJ + C_GK + h * 64 + k]) * __expf(-bc[i]);
          *(LAS unsigned short*)(Qt + t * GROW + k * 2) = (unsigned short)(pkbf(q, 0.f) & 0xffffu); *(LAS unsigned short*)(Kt + t * GROW + k * 2) = (unsigned short)(pkbf(kk, 0.f) & 0xffffu); } }
    gla_load_vt(prow0, h, VT, tid);
    __syncthreads();
    const int l15 = lane & 15, fq = lane >> 4, tt = wave & 3, vh = wave >> 2;
    bf16x8 qf[2];
#pragma unroll
    for (int ks = 0; ks < 2; ++ks) qf[ks] = *(LAS bf16x8*)(Qt + (tt * 16 + l15) * GROW + ks * 64 + fq * 16);
    f32x4 at[4];
#pragma unroll
    for (int st = 0; st < 4; ++st) { f32x4 acc = {0.f, 0.f, 0.f, 0.f};
        if (st <= tt) {
#pragma unroll
            for (int ks = 0; ks < 2; ++ks) { const bf16x8 kf = *(LAS bf16x8*)(Kt + (st * 16 + l15) * GROW + ks * 64 + fq * 16); acc = mfma16(kf, qf[ks], acc); }
            if (st == tt) {
#pragma unroll
                for (int j = 0; j < 4; ++j) if (fq * 4 + j > l15) acc[j] = 0.f; } }
        at[st] = acc; }
    bf16x8 pf[2];
#pragma unroll
    for (int cc = 0; cc < 2; ++cc) pf[cc] = __builtin_bit_cast(bf16x8, (v4u){pkbf(at[2 * cc][0], at[2 * cc][1]), pkbf(at[2 * cc][2], at[2 * cc][3]), pkbf(at[2 * cc + 1][0], at[2 * cc + 1][1]), pkbf(at[2 * cc + 1][2], at[2 * cc + 1][3])});
    const float* ST = (const float*)(a.ws + WS_ST) + (size_t)uid * 8192;
    f32x4 acc[4]; float ssq = 0.f;
#pragma unroll
    for (int vi = 0; vi < 4; ++vi) { const int vt = vh * 4 + vi; f32x4 o = {0.f, 0.f, 0.f, 0.f};
#pragma unroll
        for (int ks = 0; ks < 2; ++ks) { const f32x4* sp = (const f32x4*)(ST + (vt * 16 + l15) * 64 + ks * 32 + fq * 8); const f32x4 s0 = sp[0], s1 = sp[1];
            const bf16x8 sf = __builtin_bit_cast(bf16x8, (v4u){pkbf(s0.x, s0.y), pkbf(s0.z, s0.w), pkbf(s1.x, s1.y), pkbf(s1.z, s1.w)}); o = mfma16(sf, qf[ks], o); }
#pragma unroll
        for (int cc = 0; cc < 2; ++cc) if (2 * cc <= tt) { LAS unsigned char* vp = VT + (vt * 16 + l15) * GROW + (cc * 32 + fq * 4) * 2; const u32x2 lo = *(LAS u32x2*)vp, hi = *(LAS u32x2*)(vp + 32);
            o = mfma16(__builtin_bit_cast(bf16x8, (v4u){lo.x, lo.y, hi.x, hi.y}), pf[cc], o); }
        acc[vi] = o; ssq += (o[0] * o[0] + o[1] * o[1]) + (o[2] * o[2] + o[3] * o[3]); }
    ssq += __shfl_xor(ssq, 16); ssq += __shfl_xor(ssq, 32);
    if (fq == 0) nrm[vh * 64 + tt * 16 + l15] = ssq;
    __syncthreads();
    const int t = tt * 16 + l15; const float rstd = rsqrtf((nrm[t] + nrm[64 + t]) * (1.f / 128.f) + EPSN);
    bf16* MIX = (bf16*)(a.ws + WS_MIX) + (row0 + t) * DM + 512 + h * 128; const bf16* grp = prow0 + (size_t)t * NPJ + C_GR + h * 128; const float* gg = a.in[I_GGLA];
#pragma unroll
    for (int vi = 0; vi < 4; ++vi) { const int v0 = (vh * 4 + vi) * 16 + fq * 4; const u32x2 gw = *(const u32x2*)(grp + v0); const f32x4 g4 = *(const f32x4*)(gg + v0);
        const float r0 = bflo(gw.x), r1 = bfhi(gw.x), r2 = bflo(gw.y), r3 = bfhi(gw.y);
        const float o0 = acc[vi][0] * rstd * g4.x * (r0 / (1.f + __expf(-r0))), o1 = acc[vi][1] * rstd * g4.y * (r1 / (1.f + __expf(-r1)));
        const float o2 = acc[vi][2] * rstd * g4.z * (r2 / (1.f + __expf(-r2))), o3 = acc[vi][3] * rstd * g4.w * (r3 / (1.f + __expf(-r3)));
        *(u32x2*)(MIX + v0) = (u32x2){pkbf(o0, o1), pkbf(o2, o3)}; }
}
__device__ __forceinline__ void gla_sample_unit(const Args& a, LAS unsigned char* L, int u, int tid, int lane, int wave) {
    const int b = u >> 2, h = u & 3; const size_t row0 = (size_t)NPR + b * 8;
    const bf16* prow0 = (const bf16*)(a.ws + WS_PROJ) + row0 * NPJ;
    LAS float* BS = (LAS float*)L; LAS float* QD = BS + 512; LAS float* KD = QD + 512; LAS float* KE = KD + 512; LAS float* AB = KE + 512; LAS float* AT = AB + 64; LAS float* OP = AT + 64; LAS float* NR = OP + 4096;
    __syncthreads();
    { const int k = tid & 63, t = tid >> 6; BS[t * 64 + k] = logsig16(bf2f(prow0[(size_t)t * NPJ + C_Z + h * 64 + k]) + a.in[I_BGK][h * 64 + k]); }
    __syncthreads();
    { const int k = tid & 63, t = tid >> 6; float bt = 0.f, bl = 0.f;
#pragma unroll
      for (int i = 0; i < 8; ++i) { const float l = BS[i * 64 + k]; bl += l; if (i <= t) bt += l; }
      const float q = bf2f(prow0[(size_t)t * NPJ + C_GQ + h * 64 + k]) * 0.125f, kk = bf2f(prow0[(size_t)t * NPJ + C_GK + h * 64 + k]);
      QD[t * 64 + k] = q * __expf(bt); KD[t * 64 + k] = kk * __expf(bl - bt); KE[t * 64 + k] = kk * __expf(-bt); if (t == 0) AB[k] = __expf(bl); }
    __syncthreads();
    if (tid < 64) { const int t = tid >> 3, s = tid & 7; float acc = 0.f;
        if (s <= t) { for (int k = 0; k < 64; ++k) acc += QD[t * 64 + k] * KE[s * 64 + k]; }
        AT[t * 8 + s] = acc; }
    const int v = tid & 127, kq = tid >> 7;
    float vv[8], acc[8];
#pragma unroll
    for (int t = 0; t < 8; ++t) { vv[t] = bf2f(prow0[(size_t)t * NPJ + C_GV + h * 128 + v]); acc[t] = 0.f; }
    const float* S0 = a.in[I_SG] + (size_t)u * 8192; float* SN = a.out + O_GLS + (size_t)u * 8192;
#pragma unroll 4
    for (int kk = 0; kk < 16; ++kk) { const int k = kq * 16 + kk; const float s0 = S0[k * 128 + v]; float sn = AB[k] * s0;
#pragma unroll
        for (int t = 0; t < 8; ++t) { acc[t] += QD[t * 64 + k] * s0; sn += KD[t * 64 + k] * vv[t]; }
        SN[k * 128 + v] = sn; }
#pragma unroll
    for (int t = 0; t < 8; ++t) OP[(kq * 8 + t) * 128 + v] = acc[t];
    __syncthreads();
    float o[2];
#pragma unroll
    for (int ti = 0; ti < 2; ++ti) { const int t = kq * 2 + ti; float x = (OP[t * 128 + v] + OP[(8 + t) * 128 + v]) + (OP[(16 + t) * 128 + v] + OP[(24 + t) * 128 + v]);
#pragma unroll
        for (int s = 0; s < 8; ++s) x += AT[t * 8 + s] * vv[s];
        o[ti] = x; const float ss = wave_sum(x * x); if (lane == 0) NR[wave * 2 + ti] = ss; }
    __syncthreads();
    bf16* MIX = (bf16*)(a.ws + WS_MIX);
#pragma unroll
    for (int ti = 0; ti < 2; ++ti) { const int t = kq * 2 + ti; const float rstd = rsqrtf((NR[(kq * 2) * 2 + ti] + NR[(kq * 2 + 1) * 2 + ti]) * (1.f / 128.f) + EPSN);
        const float r = bf2f(prow0[(size_t)t * NPJ + C_GR + h * 128 + v]);
        MIX[(row0 + t) * DM + 512 + h * 128 + v] = (bf16)(pkbf(o[ti] * rstd * a.in[I_GGLA][v] * (r / (1.f + __expf(-r))), 0.f) & 0xffffu); }
}
__device__ __forceinline__ void phase6(const Args& a, int G, int bid, int lane, int wave, int MROWS) {
    const int gw = bid * 8 + wave, NGW = G * 8; const bf16* MO = (const bf16*)(a.ws + WS_MIXOUT); const float* SS = (const float*)(a.ws + WS_SS); bf16* XN = (bf16*)(a.ws + WS_XN);
    const f32x4* g1 = (const f32x4*)a.in[I_GMPOST]; const f32x4* g2 = (const f32x4*)a.in[I_GFPRE];
    for (int m = gw; m < MROWS; m += NGW) { const f32x4* xr = (const f32x4*)xrow_ptr(a, m) + lane; const u32x2* mo = (const u32x2*)(MO + (size_t)m * DM) + lane;
        const float rstd1 = rsqrtf(wave_sum(SS[(size_t)m * 16 + (lane & 15)]) * (0.25f / DM) + EPSN);
        f32x4 x1[4]; float s = 0.f;
#pragma unroll
        for (int j = 0; j < 4; ++j) { const f32x4 x = xr[64 * j], g = g1[lane + 64 * j]; const u32x2 w = mo[64 * j];
            x1[j].x = x.x + bflo(w.x) * rstd1 * g.x; x1[j].y = x.y + bfhi(w.x) * rstd1 * g.y; x1[j].z = x.z + bflo(w.y) * rstd1 * g.z; x1[j].w = x.w + bfhi(w.y) * rstd1 * g.w;
            s += (x1[j].x * x1[j].x + x1[j].y * x1[j].y) + (x1[j].z * x1[j].z + x1[j].w * x1[j].w); }
        const float rstd2 = rsqrtf(wave_sum(s) * (1.f / DM) + EPSN);
        f32x4* yo = (f32x4*)(a.out + (size_t)m * DM) + lane; u32x2* o8 = (u32x2*)(XN + (size_t)m * DM) + lane;
#pragma unroll
        for (int j = 0; j < 4; ++j) { const f32x4 g = g2[lane + 64 * j]; yo[64 * j] = x1[j];
            o8[64 * j] = (u32x2){pkbf(x1[j].x * rstd2 * g.x, x1[j].y * rstd2 * g.y), pkbf(x1[j].z * rstd2 * g.z, x1[j].w * rstd2 * g.w)}; } }
}
__device__ __forceinline__ void phase9(const Args& a, int G, int bid, int lane, int wave, int MROWS) {
    const int gw = bid * 8 + wave, NGW = G * 8; const bf16* F = (const bf16*)(a.ws + WS_F); const float* SS = (const float*)(a.ws + WS_SS); const f32x4* g1 = (const f32x4*)a.in[I_GFPOST];
    for (int m = gw; m < MROWS; m += NGW) { f32x4* yo = (f32x4*)(a.out + (size_t)m * DM) + lane; const u32x2* fo = (const u32x2*)(F + (size_t)m * DM) + lane;
        const float rstd = rsqrtf(wave_sum(SS[(size_t)m * 16 + (lane & 15)]) * (0.25f / DM) + EPSN);
#pragma unroll
        for (int j = 0; j < 4; ++j) { f32x4 x = yo[64 * j]; const f32x4 g = g1[lane + 64 * j]; const u32x2 w = fo[64 * j];
            x.x += bflo(w.x) * rstd * g.x; x.y += bfhi(w.x) * rstd * g.y; x.z += bflo(w.y) * rstd * g.z; x.w += bfhi(w.y) * rstd * g.w; yo[64 * j] = x; } }
}
__device__ __forceinline__ void phase6_sample(const Args& a, int G, int bid, int lane, int wave) {
    const int gw = bid * 8 + wave, NGW = G * 8; bf16* XN = (bf16*)(a.ws + WS_XN); const f32x4* g1 = (const f32x4*)a.in[I_GMPOST]; const f32x4* g2 = (const f32x4*)a.in[I_GFPRE];
    for (int r = gw; r < NSR; r += NGW) { const int m = NPR + r; const f32x4* xr = (const f32x4*)xrow_ptr(a, m) + lane; const f32x4* pl = (const f32x4*)(a.ws + WS_OPL) + (size_t)r * (DM / 4) + lane;
        f32x4 mo[4]; float s1 = 0.f;
#pragma unroll
        for (int j = 0; j < 4; ++j) mo[j] = pl[64 * j];
#pragma unroll 2
        for (int sp = 1; sp < 8; ++sp) {
#pragma unroll
            for (int j = 0; j < 4; ++j) mo[j] += pl[(size_t)sp * (NSR * DM / 4) + 64 * j]; }
#pragma unroll
        for (int j = 0; j < 4; ++j) { const f32x4 t = mo[j]; s1 += (t.x * t.x + t.y * t.y) + (t.z * t.z + t.w * t.w); }
        const float rstd1 = rsqrtf(wave_sum(s1) * (1.f / DM) + EPSN);
        f32x4 x1[4]; float s = 0.f;
#pragma unroll
        for (int j = 0; j < 4; ++j) { const f32x4 x = xr[64 * j], g = g1[lane + 64 * j]; x1[j] = x + mo[j] * rstd1 * g; s += (x1[j].x * x1[j].x + x1[j].y * x1[j].y) + (x1[j].z * x1[j].z + x1[j].w * x1[j].w); }
        const float rstd2 = rsqrtf(wave_sum(s) * (1.f / DM) + EPSN);
        f32x4* yo = (f32x4*)(a.out + (size_t)m * DM) + lane; u32x2* o8 = (u32x2*)(XN + (size_t)m * DM) + lane;
#pragma unroll
        for (int j = 0; j < 4; ++j) { const f32x4 g = g2[lane + 64 * j]; yo[64 * j] = x1[j];
            o8[64 * j] = (u32x2){pkbf(x1[j].x * rstd2 * g.x, x1[j].y * rstd2 * g.y), pkbf(x1[j].z * rstd2 * g.z, x1[j].w * rstd2 * g.w)}; } }
}
__device__ __forceinline__ float* dpl_plane(unsigned char* ws, int sp) { return (float*)(ws + (sp < 15 ? WS_DPL_A + (size_t)sp * 4 * MiB : WS_DPL_B)); }
__device__ __forceinline__ void phase9_sample(const Args& a, int G, int bid, int lane, int wave) {
    const int gw = bid * 8 + wave, NGW = G * 8; const f32x4* g1 = (const f32x4*)a.in[I_GFPOST];
    for (int r = gw; r < NSR; r += NGW) { const int m = NPR + r; f32x4 f[4]; float s1 = 0.f;
#pragma unroll
        for (int j = 0; j < 4; ++j) f[j] = (f32x4){0.f, 0.f, 0.f, 0.f};
#pragma unroll 2
        for (int sp = 0; sp < 16; ++sp) { const f32x4* pl = (const f32x4*)dpl_plane(a.ws, sp) + (size_t)r * (DM / 4) + lane;
#pragma unroll
            for (int j = 0; j < 4; ++j) f[j] += pl[64 * j]; }
#pragma unroll
        for (int j = 0; j < 4; ++j) s1 += (f[j].x * f[j].x + f[j].y * f[j].y) + (f[j].z * f[j].z + f[j].w * f[j].w);
        const float rstd = rsqrtf(wave_sum(s1) * (1.f / DM) + EPSN);
        f32x4* yo = (f32x4*)(a.out + (size_t)m * DM) + lane;
#pragma unroll
        for (int j = 0; j < 4; ++j) yo[64 * j] = yo[64 * j] + f[j] * rstd * g1[lane + 64 * j]; }
}
__device__ __forceinline__ void up_fixup_sample(const Args& a, int G, int bid, int tid) {
    const int gt = bid * 512 + tid, NGT = G * 512; bf16* U = (bf16*)(a.ws + WS_U) + (size_t)NPR * FF;
    for (int e = gt; e < NSR * FF / 4; e += NGT) { f32x4 t = ((const f32x4*)(a.ws + WS_UPL_B))[e];
#pragma unroll
        for (int sp = 0; sp < 3; ++sp) t += ((const f32x4*)(a.ws + WS_UPL_A + (size_t)sp * 16 * MiB))[e];
        const float x0 = fmaxf(t.x, 0.f), x1 = fmaxf(t.y, 0.f), x2 = fmaxf(t.z, 0.f), x3 = fmaxf(t.w, 0.f);
        ((u32x2*)U)[e] = (u32x2){pkbf(x0 * x0, x1 * x1), pkbf(x2 * x2, x3 * x3)}; }
}
__device__ __forceinline__ unsigned char* launder_s(unsigned char* p) { asm volatile("" : "+s"(p)); return p; }
__global__ void __launch_bounds__(512, 2) mk_fwd(Args args) {
    extern __shared__ __attribute__((aligned(16))) unsigned char lds[];
    LAS unsigned char* L = (LAS unsigned char*)lds;
    volatile LAS unsigned* MISC = (volatile LAS unsigned*)(L + MISC_OFF);
    const int tid = threadIdx.x, lane = tid & 63, wave = __builtin_amdgcn_readfirstlane(tid >> 6);
    const int G = gridDim.x, bid = blockIdx.x;
    if (tid < 64) MISC[tid] = 0u;
    __syncthreads();
    if (args.never) cooperative_groups::this_grid().sync();
    unsigned* barw = (unsigned*)(args.ws + WS_CTL) + CW_BAR;
    XcdBarrier bar; bar.bar = barw; bar.x = 0; bar.st = nullptr;
    if (args.use_bar) bar = xcd_barrier_post(barw, MISC + 8);
    const int lo = args.ph_lo, hi = args.ph_hi;
#define IN(k) (lo <= (k) && (k) < hi)
#define SEAM(k) do { if (IN(k) && IN((k) + 1)) xcd_barrier(bar); } while (0)
    if (IN(0)) { phase0(args, L, G, bid, tid, lane, wave); SEAM(0); }
    if (IN(1)) { unsigned char* ws = launder_s(args.ws); pg8::Gemm g{(const bf16*)(ws + WS_XN), (const bf16*)(ws + WS_WIN), MR, NPJ, DM}; pg8::StaticOrder S; S.init(MR, NPJ, G, bid, DM);
        pg8::EpiMk<0, false> E{(bf16*)(ws + WS_PROJ), NPJ, nullptr};
        pg8::gemm_phase<pg8::EpiMk<0, false>, pg8::StaticOrder, true, true>(L, g, S, E); SEAM(1); }
    if (IN(2)) {
        for (int u = bid; u < 256; u += G) attn_prompt_unit(args, L, u, tid, lane, wave);
        for (int u = bid; u < 256; u += G) attn_sample_unit(args, L, u, tid, lane, wave);
        for (int u = bid; u < 1024; u += G) gla_local_unit(args, L, u, tid, lane, wave);
        for (int u = bid; u < 512; u += G) gla_sample_unit(args, L, u, tid, lane, wave);
        SEAM(2); }
    if (IN(3)) { unsigned char* ws = launder_s(args.ws); const int gs = G >> 1;
        if (bid < gs) { for (int id = bid * 512 + tid; id < 65536; id += gs * 512) gla_scan(args, id); }
        else { pg8::Gemm g{(const bf16*)(ws + WS_MIX), (const bf16*)(ws + WS_WOUT), MR, DM, DM};
            pg8::SplitOrder S{bid - gs, G - gs, 128, 8, 4, 128, (float*)(ws + WS_OPL), (size_t)NSR * DM, 8, nullptr}; pg8::EpiPlane E{DM};
            pg8::gemm_phase<pg8::EpiPlane, pg8::SplitOrder, true, true>(L, g, S, E); }
        SEAM(3); }
    if (IN(4)) { for (int u = bid; u < 1024; u += G) gla_out_unit(args, L, u, tid, lane, wave); phase6_sample(args, G, bid, lane, wave); SEAM(4); }
    if (IN(5)) { unsigned char* ws = launder_s(args.ws); { pg8::Gemm g{(const bf16*)(ws + WS_MIX), (const bf16*)(ws + WS_WOUT), NPR, DM, DM}; pg8::StaticOrder S; S.init(NPR, DM, G, bid, DM);
          pg8::EpiMk<0, true> E{(bf16*)(ws + WS_MIXOUT), DM, (float*)(ws + WS_SS)};
          pg8::gemm_phase<pg8::EpiMk<0, true>, pg8::StaticOrder, true, true>(L, g, S, E); }
        { pg8::Gemm g{(const bf16*)(ws + WS_XN), (const bf16*)(ws + WS_WUP), MR, FF, DM};
          pg8::SplitOrder S{bid, G, 256, 4, 16, 256, (float*)(ws + WS_UPL_A), (size_t)4 * MiB, 3, (float*)(ws + WS_UPL_B)}; pg8::EpiPlane E{FF};
          pg8::gemm_phase<pg8::EpiPlane, pg8::SplitOrder, true, true>(L, g, S, E); }
        SEAM(5); }
    if (IN(6)) { phase6(args, G, bid, lane, wave, NPR); up_fixup_sample(args, G, bid, tid); SEAM(6); }
    if (IN(7)) { unsigned char* ws = launder_s(args.ws); { pg8::Gemm g{(const bf16*)(ws + WS_XN), (const bf16*)(ws + WS_WUP), NPR, FF, DM}; pg8::StaticOrder S; S.init(NPR, FF, G, bid, DM);
          pg8::EpiMk<1, false> E{(bf16*)(ws + WS_U), FF, nullptr};
          pg8::gemm_phase<pg8::EpiMk<1, false>, pg8::StaticOrder, true, true>(L, g, S, E); }
        { pg8::Gemm g{(const bf16*)(ws + WS_U), (const bf16*)(ws + WS_WDN), MR, DM, FF};
          pg8::SplitOrder S{bid, G, 256, 16, 4, 256, (float*)(ws + WS_DPL_A), (size_t)1 * MiB, 15, (float*)(ws + WS_DPL_B)}; pg8::EpiPlane E{DM};
          pg8::gemm_phase<pg8::EpiPlane, pg8::SplitOrder, true, true>(L, g, S, E); }
        SEAM(7); }
    if (IN(8)) { unsigned char* ws = launder_s(args.ws); pg8::Gemm g{(const bf16*)(ws + WS_U), (const bf16*)(ws + WS_WDN), NPR, DM, FF}; pg8::StaticOrder S; S.init(NPR, DM, G, bid, FF);
        pg8::EpiMk<0, true> E{(bf16*)(ws + WS_F), DM, (float*)(ws + WS_SS)};
        pg8::gemm_phase<pg8::EpiMk<0, true>, pg8::StaticOrder, true, true>(L, g, S, E);
        phase9_sample(args, G, bid, lane, wave); SEAM(8); }
    if (IN(9)) { phase9(args, G, bid, lane, wave, NPR); }
#undef IN
#undef SEAM
}

extern "C" void kernel_launch(void* const* d_in, const int* in_sizes, int n_in, void* d_out, int out_size, void* d_ws, size_t ws_size, hipStream_t stream) {
    static int grid = 0;
    if (grid == 0) {
        if (n_in != 17 || ws_size < WS_END) { fprintf(stderr, "kernel_launch: unexpected n_in %d / ws %zu\n", n_in, ws_size); grid = -1; return; }
        int dev = 0, cus = 0, per_cu = 0;
        if (hipGetDevice(&dev) != hipSuccess || hipDeviceGetAttribute(&cus, hipDeviceAttributeMultiprocessorCount, dev) != hipSuccess) { grid = -1; return; }
        if (hipFuncSetAttribute((const void*)mk_fwd, hipFuncAttributeMaxDynamicSharedMemorySize, LDS_BYTES) != hipSuccess) { fprintf(stderr, "kernel_launch: hipFuncSetAttribute failed\n"); grid = -1; return; }
        if (hipOccupancyMaxActiveBlocksPerMultiprocessor(&per_cu, (const void*)mk_fwd, 512, LDS_BYTES) != hipSuccess || per_cu < 1) { fprintf(stderr, "kernel_launch: occupancy query says %d\n", per_cu); per_cu = 1; }
        (void)hipGetLastError();
        grid = cus * 1;
        if (grid & 1) grid -= 1;
    }
    if (grid < 0) return;
    (void)hipMemsetAsync((char*)d_ws + WS_CTL, 0, CTL_ZERO_BYTES, stream);
    Args a{};
    for (int i = 0; i < 17; ++i) a.in[i] = (const float*)d_in[i];
    a.out = (float*)d_out; a.ws = (unsigned char*)d_ws;
    for (int i = 0; i < 32; ++i) a.inv_freq[i] = pow(10000.0, -(double)i / 32.0);
    a.never = 0;
#if MK_N_LAUNCHES == 1
    a.ph_lo = 0; a.ph_hi = NPH; a.use_bar = 1;
    void* kargs[] = {&a};
    hipError_t e = hipLaunchCooperativeKernel((const void*)mk_fwd, dim3(grid), dim3(512), kargs, LDS_BYTES, stream);
    if (e != hipSuccess) fprintf(stderr, "kernel_launch: cooperative launch failed: %s (grid %d)\n", hipGetErrorString(e), grid);
#else
    a.use_bar = 0;
    for (int p = 0; p < NPH; ++p) { a.ph_lo = p; a.ph_hi = p + 1; hipLaunchKernelGGL(mk_fwd, dim3(grid), dim3(512), LDS_BYTES, stream, a); }
#endif
}
```
